# Optimizing an MI355X kernel written in HIP

```python
import math
import jax, jax.numpy as jnp
from jax import lax
import numpy as np

D_MODEL = 1024
BATCH = 4
SEQ = 8192
DEPTH = 2

MLA_HEADS = 8
MLA_Q_LORA = 512
MLA_KV_LORA = 256
MLA_NOPE = 128
MLA_ROPE = 64
MLA_V = 128
ROPE_THETA = 10000.0
DIFF_HEADS = 8
DIFF_HEAD_DIM = 64
D_FF_DENSE = 2816
N_EXPERTS = 8
TOP_K = 2
D_FF_EXPERT = 3584
Q_BLOCK = 128
EPS = 1e-6
N_DENSE = (DEPTH + 1) // 2
N_MOE = DEPTH // 2

W_CQ = MLA_Q_LORA
W_CKV = MLA_KV_LORA
W_KR = MLA_ROPE
W_DQ = DIFF_HEADS * 2 * DIFF_HEAD_DIM
W_DK = DIFF_HEADS * 2 * DIFF_HEAD_DIM
W_DV = DIFF_HEADS * 2 * DIFF_HEAD_DIM
D_IN = W_CQ + W_CKV + W_KR + W_DQ + W_DK + W_DV
MLA_OUT = MLA_HEADS * MLA_V
DIFF_OUT = DIFF_HEADS * 2 * DIFF_HEAD_DIM

kernel_name = "hybrid_mla_diffattn_gated_moe_encoder"


def rms_norm(x, gain):
    xf = x.astype(jnp.float32)
    y = xf * lax.rsqrt(jnp.mean(xf * xf, axis=-1, keepdims=True) + EPS)
    return (y * gain.astype(jnp.float32)).astype(x.dtype)


def apply_rope(x, pos):
    half = x.shape[-1] // 2
    inv_freq = ROPE_THETA ** (-jnp.arange(half, dtype=jnp.float32) / half)
    ang = pos.astype(jnp.float32)[..., None] * inv_freq
    ang = ang.reshape(ang.shape[:2] + (1,) * (x.ndim - 3) + (half,))
    cos, sin = jnp.cos(ang), jnp.sin(ang)
    xf = x.astype(jnp.float32)
    x1, x2 = xf[..., :half], xf[..., half:]
    return jnp.concatenate([x1 * cos - x2 * sin, x2 * cos + x1 * sin], axis=-1).astype(x.dtype)


def alibi_slopes():
    return 2.0 ** (-8.0 * jnp.arange(1, DIFF_HEADS + 1, dtype=jnp.float32) / DIFF_HEADS)


def to_blocks(a):
    b, s = a.shape[:2]
    a = a.reshape((b, s // Q_BLOCK, Q_BLOCK) + a.shape[2:])
    return jnp.moveaxis(a, 1, 0)


def from_blocks(a):
    a = jnp.moveaxis(a, 0, 1)
    return a.reshape((a.shape[0], a.shape[1] * a.shape[2]) + a.shape[3:])


def mla_attention(c_q, c_kv, k_rope, pos, q_norm_g, kv_norm_g, w_uq, w_ukv,
                  qn_nope_g, qn_rope_g, kn_nope_g, kn_rope_g):
    b, s, _ = c_q.shape
    q = (rms_norm(c_q, q_norm_g) @ w_uq).reshape(b, s, MLA_HEADS, MLA_NOPE + MLA_ROPE)
    kv = (rms_norm(c_kv, kv_norm_g) @ w_ukv).reshape(b, s, MLA_HEADS, MLA_NOPE + MLA_V)
    q_nope = rms_norm(q[..., :MLA_NOPE], qn_nope_g)
    q_rope = apply_rope(rms_norm(q[..., MLA_NOPE:], qn_rope_g), pos)
    k_nope = rms_norm(kv[..., :MLA_NOPE], kn_nope_g)
    v = kv[..., MLA_NOPE:]
    k_r = apply_rope(rms_norm(k_rope, kn_rope_g), pos)
    scale = (MLA_NOPE + MLA_ROPE) ** -0.5

    def block(args):
        qn, qr = args
        sc = (jnp.einsum('bqhn,bkhn->bhqk', qn, k_nope)
              + jnp.einsum('bqhr,bkr->bhqk', qr, k_r))
        p = jax.nn.softmax(sc.astype(jnp.float32) * scale, axis=-1).astype(v.dtype)
        return jnp.einsum('bhqk,bkhv->bqhv', p, v)

    o = from_blocks(lax.map(block, (to_blocks(q_nope), to_blocks(q_rope))))
    return o.reshape(b, s, MLA_OUT)


def diff_attention(q, k, v, pos, qn_g, kn_g, lam_q1, lam_k1, lam_q2, lam_k2,
                   subln_g, lambda_init):
    b, s, _ = q.shape
    q = rms_norm(q.reshape(b, s, DIFF_HEADS, 2, DIFF_HEAD_DIM), qn_g)
    k = rms_norm(k.reshape(b, s, DIFF_HEADS, 2, DIFF_HEAD_DIM), kn_g)
    v = v.reshape(b, s, DIFF_HEADS, 2 * DIFF_HEAD_DIM)
    lam = (jnp.exp(jnp.sum(lam_q1.astype(jnp.float32) * lam_k1.astype(jnp.float32)))
           - jnp.exp(jnp.sum(lam_q2.astype(jnp.float32) * lam_k2.astype(jnp.float32)))
           + lambda_init)
    slopes = alibi_slopes()
    pos_f = pos.astype(jnp.float32)
    scale = DIFF_HEAD_DIM ** -0.5

    def block(args):
        qb, pq = args
        sc = jnp.einsum('bqhcd,bkhcd->bhcqk', qb, k).astype(jnp.float32) * scale
        dist = jnp.abs(pq[:, :, None] - pos_f[:, None, :])
        sc = sc - slopes[None, :, None, None, None] * dist[:, None, None]
        p = jax.nn.softmax(sc, axis=-1)
        w = (p[:, :, 0] - lam * p[:, :, 1]).astype(v.dtype)
        return jnp.einsum('bhqk,bkhv->bqhv', w, v)

    o = from_blocks(lax.map(block, (to_blocks(q), to_blocks(pos_f))))
    o = rms_norm(o, subln_g) * (1.0 - lambda_init)
    return o.reshape(b, s, DIFF_OUT)


def swiglu(h, w_gate, w_up, w_down):
    return (jax.nn.silu(h @ w_gate) * (h @ w_up)) @ w_down


def moe_swiglu(h, w_router, w_gate_e, w_up_e, w_down_e):
    b, s, d = h.shape
    t = h.reshape(b * s, d)
    logits = (t @ w_router).astype(jnp.float32)
    top_vals, top_idx = lax.top_k(logits, TOP_K)
    top_w = jax.nn.softmax(top_vals, axis=-1)
    combine = jnp.sum(jax.nn.one_hot(top_idx, N_EXPERTS, dtype=jnp.float32)
                      * top_w[..., None], axis=1).astype(t.dtype)
    out = jnp.zeros_like(t)
    for e in range(N_EXPERTS):
        y = swiglu(t, w_gate_e[e], w_up_e[e], w_down_e[e])
        out = out + combine[:, e:e + 1] * y
    return out.reshape(b, s, d)


def setup_inputs(seed: int = 0) -> dict:
    key = jax.random.key(seed)
    keys = iter(jax.random.split(key, 64))

    def w(shape, fan_in):
        return jax.random.normal(next(keys), shape, jnp.float32) * (fan_in ** -0.5)

    def gain(shape):
        return 1.0 + 0.02 * jax.random.normal(next(keys), shape, jnp.float32)

    def small(shape, std):
        return std * jax.random.normal(next(keys), shape, jnp.float32)

    L = DEPTH
    return {
        "x": jax.random.normal(next(keys), (BATCH, SEQ, D_MODEL), jnp.float32),
        "positions": jnp.broadcast_to(jnp.arange(SEQ, dtype=jnp.int32), (BATCH, SEQ)),
        "attn_norm_g": gain((L, D_MODEL)),
        "w_in": w((L, D_MODEL, D_IN), D_MODEL),
        "w_gate": w((L, D_MODEL, 2 * D_MODEL), D_MODEL),
        "mla_q_norm_g": gain((L, MLA_Q_LORA)),
        "mla_kv_norm_g": gain((L, MLA_KV_LORA)),
        "mla_w_uq": w((L, MLA_Q_LORA, MLA_HEADS * (MLA_NOPE + MLA_ROPE)), MLA_Q_LORA),
        "mla_w_ukv": w((L, MLA_KV_LORA, MLA_HEADS * (MLA_NOPE + MLA_V)), MLA_KV_LORA),
        "mla_qn_nope_g": gain((L, MLA_NOPE)),
        "mla_qn_rope_g": gain((L, MLA_ROPE)),
        "mla_kn_nope_g": gain((L, MLA_NOPE)),
        "mla_kn_rope_g": gain((L, MLA_ROPE)),
        "diff_qn_g": gain((L, DIFF_HEAD_DIM)),
        "diff_kn_g": gain((L, DIFF_HEAD_DIM)),
        "diff_lam_q1": small((L, DIFF_HEAD_DIM), 0.1),
        "diff_lam_k1": small((L, DIFF_HEAD_DIM), 0.1),
        "diff_lam_q2": small((L, DIFF_HEAD_DIM), 0.1),
        "diff_lam_k2": small((L, DIFF_HEAD_DIM), 0.1),
        "diff_subln_g": gain((L, 2 * DIFF_HEAD_DIM)),
        "w_branch_a": w((L, MLA_OUT, D_MODEL), MLA_OUT),
        "w_branch_b": w((L, DIFF_OUT, D_MODEL), DIFF_OUT),
        "w_out": w((L, D_MODEL, D_MODEL), D_MODEL),
        "ffn_norm_g": gain((L, D_MODEL)),
        "dense_w_gate": w((N_DENSE, D_MODEL, D_FF_DENSE), D_MODEL),
        "dense_w_up": w((N_DENSE, D_MODEL, D_FF_DENSE), D_MODEL),
        "dense_w_down": w((N_DENSE, D_FF_DENSE, D_MODEL), D_FF_DENSE),
        "moe_w_router": w((N_MOE, D_MODEL, N_EXPERTS), D_MODEL),
        "moe_w_gate": w((N_MOE, N_EXPERTS, D_MODEL, D_FF_EXPERT), D_MODEL),
        "moe_w_up": w((N_MOE, N_EXPERTS, D_MODEL, D_FF_EXPERT), D_MODEL),
        "moe_w_down": w((N_MOE, N_EXPERTS, D_FF_EXPERT, D_MODEL), D_FF_EXPERT),
    }


def reference(x, positions, attn_norm_g, w_in, w_gate, mla_q_norm_g, mla_kv_norm_g,
              mla_w_uq, mla_w_ukv, mla_qn_nope_g, mla_qn_rope_g, mla_kn_nope_g,
              mla_kn_rope_g, diff_qn_g, diff_kn_g, diff_lam_q1, diff_lam_k1,
              diff_lam_q2, diff_lam_k2, diff_subln_g, w_branch_a, w_branch_b, w_out,
              ffn_norm_g, dense_w_gate, dense_w_up, dense_w_down, moe_w_router,
              moe_w_gate, moe_w_up, moe_w_down):
    splits = [W_CQ, W_CQ + W_CKV, W_CQ + W_CKV + W_KR, W_CQ + W_CKV + W_KR + W_DQ,
              W_CQ + W_CKV + W_KR + W_DQ + W_DK]
    for layer in range(DEPTH):
        h = rms_norm(x, attn_norm_g[layer])
        c_q, c_kv, k_rope, dq, dk, dv = jnp.split(h @ w_in[layer], splits, axis=-1)
        o_a = mla_attention(c_q, c_kv, k_rope, positions,
                            mla_q_norm_g[layer], mla_kv_norm_g[layer],
                            mla_w_uq[layer], mla_w_ukv[layer],
                            mla_qn_nope_g[layer], mla_qn_rope_g[layer],
                            mla_kn_nope_g[layer], mla_kn_rope_g[layer])
        lambda_init = 0.8 - 0.6 * math.exp(-0.3 * layer)
        o_b = diff_attention(dq, dk, dv, positions, diff_qn_g[layer], diff_kn_g[layer],
                             diff_lam_q1[layer], diff_lam_k1[layer],
                             diff_lam_q2[layer], diff_lam_k2[layer],
                             diff_subln_g[layer], lambda_init)
        g_a, g_b = jnp.split(jax.nn.sigmoid(h @ w_gate[layer]), 2, axis=-1)
        merged = g_a * (o_a @ w_branch_a[layer]) + g_b * (o_b @ w_branch_b[layer])
        x = x + merged @ w_out[layer]
        h = rms_norm(x, ffn_norm_g[layer])
        j = layer // 2
        if layer % 2 == 0:
            x = x + swiglu(h, dense_w_gate[j], dense_w_up[j], dense_w_down[j])
        else:
            x = x + moe_swiglu(h, moe_w_router[j], moe_w_gate[j], moe_w_up[j], moe_w_down[j])
    return x
```

```cpp
#include <hip/hip_runtime.h>
#include <cstdio>
#include <cstdint>

#define LAS __attribute__((address_space(3)))
#define GAS __attribute__((address_space(1)))
typedef unsigned short bf16;
typedef short bf16x8 __attribute__((ext_vector_type(8)));
typedef short s16x4 __attribute__((ext_vector_type(4)));
typedef float f32x4 __attribute__((ext_vector_type(4)));
typedef float f32x16 __attribute__((ext_vector_type(16)));
typedef unsigned u32x4 __attribute__((ext_vector_type(4)));
typedef unsigned u32x2 __attribute__((ext_vector_type(2)));

constexpr int NB = 4, SEQ = 8192, T = NB * SEQ, DM = 1024, NLAYER = 2;
constexpr int MLA_H = 8, CQ = 512, CKV = 256, NOPE = 128, ROPE = 64, MLAV = 128, QHD = NOPE + ROPE;
constexpr int DH = 8, DHD = 64;
constexpr int FFD = 2816, NEXP = 8, FFE = 3584;
constexpr int DIN = CQ + CKV + ROPE + 3 * DM;
constexpr float EPS = 1e-6f;
constexpr int NPMAX = T + NEXP * 256;

typedef float f32x2_t __attribute__((ext_vector_type(2))); typedef __bf16 bf16x2_t __attribute__((ext_vector_type(2)));
__device__ __forceinline__ unsigned cvt_pk_bf16(float lo, float hi) { f32x2_t v = {lo, hi}; bf16x2_t b = __builtin_convertvector(v, bf16x2_t); return __builtin_bit_cast(unsigned, b); }
__device__ __forceinline__ float bf_lo(unsigned w) { return __uint_as_float(w << 16); }
__device__ __forceinline__ float bf_hi(unsigned w) { return __uint_as_float(w & 0xffff0000u); }
__device__ __forceinline__ void unpack8(const u32x4 v, float (&f)[8]) { f[0] = bf_lo(v.x); f[1] = bf_hi(v.x); f[2] = bf_lo(v.y); f[3] = bf_hi(v.y); f[4] = bf_lo(v.z); f[5] = bf_hi(v.z); f[6] = bf_lo(v.w); f[7] = bf_hi(v.w); }
__device__ __forceinline__ u32x4 pack8(const float (&f)[8]) { u32x4 v; v.x = cvt_pk_bf16(f[0], f[1]); v.y = cvt_pk_bf16(f[2], f[3]); v.z = cvt_pk_bf16(f[4], f[5]); v.w = cvt_pk_bf16(f[6], f[7]); return v; }
__device__ __forceinline__ float ssq8(const float (&f)[8]) { float s = 0.f;
#pragma unroll
    for (int e = 0; e < 8; ++e) s += f[e] * f[e];
    return s; }
template <int M> __device__ __forceinline__ float xshfl(float v) { return __int_as_float(__builtin_amdgcn_ds_swizzle(__float_as_int(v), 0x1F | (M << 10))); }
__device__ __forceinline__ float wave_sum(float v) {
    v += xshfl<1>(v); v += xshfl<2>(v); v += xshfl<4>(v); v += xshfl<8>(v); v += xshfl<16>(v);
    auto rr = __builtin_amdgcn_permlane32_swap(__float_as_uint(v), __float_as_uint(v), false, false);
    return __uint_as_float(rr[0]) + __uint_as_float(rr[1]);
}
__device__ __forceinline__ int fresh_tid(int wave_s) { unsigned z = 0u; asm volatile("" : "+v"(z)); return wave_s * 64 + (int)__builtin_amdgcn_mbcnt_hi(~0u, __builtin_amdgcn_mbcnt_lo(~0u, z)); }
__device__ __forceinline__ float wave_max(float v) {
    v = fmaxf(v, xshfl<1>(v)); v = fmaxf(v, xshfl<2>(v)); v = fmaxf(v, xshfl<4>(v)); v = fmaxf(v, xshfl<8>(v)); v = fmaxf(v, xshfl<16>(v));
    auto rr = __builtin_amdgcn_permlane32_swap(__float_as_uint(v), __float_as_uint(v), false, false);
    return fmaxf(__uint_as_float(rr[0]), __uint_as_float(rr[1]));
}
__device__ __forceinline__ float sigmoid_f(float x) { return __builtin_amdgcn_rcpf(1.0f + __expf(-x)); }

#ifndef FP8_UPD
#define FP8_UPD 0
#endif
#ifndef FP8_UP
#define FP8_UP 1
#endif
#ifndef FP8_DND
#define FP8_DND 0
#endif
#ifndef FP8_DN
#define FP8_DN 1
#endif
typedef int v8i32 __attribute__((ext_vector_type(8)));
__device__ __forceinline__ float clamp_fp8(float v) { return __builtin_amdgcn_fmed3f(v, -448.0f, 448.0f); }
__device__ __forceinline__ unsigned pk4_fp8(float a, float b, float c, float d) { int w = 0; w = __builtin_amdgcn_cvt_pk_fp8_f32(clamp_fp8(a), clamp_fp8(b), w, false); w = __builtin_amdgcn_cvt_pk_fp8_f32(clamp_fp8(c), clamp_fp8(d), w, true); return (unsigned)w; }
constexpr float MLA_SQS = 0.32267156f;
#define MLA_GG8 1
#define MLA_UPF8 1
#define MLA_G1F8 1
#define MLA_GA8 1
static_assert(!MLA_GG8 || MLA_G1F8, "g_a in fp8 reads the e4m3 copy of h");
constexpr int SC_OA = 0x79797979;
#define MLA_FP8 1
constexpr int SC_ONE = 0x7F7F7F7F, SC_W = 0x7A7A7A7A, SC_ACT = 0x7D7D7D7D;
namespace pg8 {
#define PG8_LAS __attribute__((address_space(3)))
typedef unsigned short bf16_t;
constexpr int BM = 256, BK = 64, HALF = 128, HTB = HALF * BK * 2  , STAGE_BYTES = 8 * HTB, NXCD = 8, WGM = 8;

__host__ __device__ __forceinline__ int lds_byte(int r, int c) { const int st = (r >> 4) * 2 + (c >> 5), rr = r & 15, cc = c & 31, ob = rr * 64 + cc * 2; return st * 1024 + (ob ^ (((ob >> 9) & 1) << 5)); }
__host__ __device__ __forceinline__ void stage_rc(int b, int& R, int& C) { const int st = b / 1024, sb = b % 1024, swz = sb ^ (((sb >> 9) & 1) << 5); R = (st >> 1) * 16 + swz / 64; C = (st & 1) * 32 + (swz % 64) / 2; }
__host__ __device__ __forceinline__ int perm32(int rho) { const int n = rho >> 4, i = rho & 15; return 8 * (i >> 2) + 4 * n + (i & 3); }

struct Unit { int pm, pn; };

struct StaticOrder {
    int nM, nN, nwg, G, c;
    __host__ __device__ void init(int M, int N, int G_, int c_) { nM = M / BM; nN = N / BM; nwg = nM * nN; G = G_; c = c_; }
    __host__ __device__ bool next(int i, Unit& u) const {
        const long L = (long)i * G + c; if (L >= nwg) return false;
        int wgid = (int)L; { const int q = nwg / NXCD, r = nwg % NXCD, xcd = wgid % NXCD, off = wgid / NXCD; wgid = (xcd < r ? xcd * (q + 1) : r * (q + 1) + (xcd - r) * q) + off; }
        const int nig = WGM * nN, gid = wgid / nig, fm = gid * WGM, gsz = (nM - fm) < WGM ? (nM - fm) : WGM;
        u.pm = fm + ((wgid % nig) % gsz); u.pn = (wgid % nig) / gsz; return true;
    }
};

struct ProbPlain {
    static constexpr bool GATHER = false; static constexpr int ESZ = 2;
    const bf16_t* A; int lda; const bf16_t* Bt; int ldb; int K;
    __device__ __forceinline__ const char* a_tile(const Unit& u) const { return (const char*)(A + (size_t)u.pm * BM * lda); }
    __device__ __forceinline__ const char* b_tile(const Unit& u) const { return (const char*)(Bt + (size_t)u.pn * BM * ldb); }
    __device__ __forceinline__ unsigned a_row(const Unit&, int r) const { return (unsigned)r; }
};
struct ProbMoeUp {
    static constexpr bool GATHER = true; static constexpr int ESZ = 2;
    const bf16_t* A; int lda; const bf16_t* Bt; int ldb; int K; size_t estride; const int* tok; const int* tex;
    __device__ __forceinline__ const char* a_tile(const Unit&) const { return (const char*)A; }
    __device__ __forceinline__ const char* b_tile(const Unit& u) const { const int e = __builtin_amdgcn_readfirstlane(tex[u.pm]); return (const char*)(Bt + (size_t)e * estride + (size_t)u.pn * BM * ldb); }
    __device__ __forceinline__ unsigned a_row(const Unit& u, int r) const { const int t = tok[u.pm * BM + r]; return (unsigned)(t < 0 ? 0 : t); }
};
struct ProbMoeDown {
    static constexpr bool GATHER = false; static constexpr int ESZ = 2;
    const bf16_t* A; int lda; const bf16_t* Bt; int ldb; int K; size_t estride; const int* tex;
    __device__ __forceinline__ const char* a_tile(const Unit& u) const { return (const char*)(A + (size_t)u.pm * BM * lda); }
    __device__ __forceinline__ const char* b_tile(const Unit& u) const { const int e = __builtin_amdgcn_readfirstlane(tex[u.pm]); return (const char*)(Bt + (size_t)e * estride + (size_t)u.pn * BM * ldb); }
    __device__ __forceinline__ unsigned a_row(const Unit&, int r) const { return (unsigned)r; }
};

struct ProbPlain8 {
    static constexpr bool GATHER = false; static constexpr int ESZ = 1;
    const unsigned char* A; int lda; const unsigned char* Bt; int ldb; int K; int sa, sb;
    __device__ __forceinline__ const char* a_tile(const Unit& u) const { return (const char*)(A + (size_t)u.pm * BM * lda); }
    __device__ __forceinline__ const char* b_tile(const Unit& u) const { return (const char*)(Bt + (size_t)u.pn * BM * ldb); }
    __device__ __forceinline__ unsigned a_row(const Unit&, int r) const { return (unsigned)r; }
};
struct ProbMoeUp8 {
    static constexpr bool GATHER = true; static constexpr int ESZ = 1;
    const unsigned char* A; int lda; const unsigned char* Bt; int ldb; int K; size_t estride; const int* tok; const int* tex; int sa, sb;
    __device__ __forceinline__ const char* a_tile(const Unit&) const { return (const char*)A; }
    __device__ __forceinline__ const char* b_tile(const Unit& u) const { const int e = __builtin_amdgcn_readfirstlane(tex[u.pm]); return (const char*)(Bt + (size_t)e * estride + (size_t)u.pn * BM * ldb); }
    __device__ __forceinline__ unsigned a_row(const Unit& u, int r) const { const int t = tok[u.pm * BM + r]; return (unsigned)(t < 0 ? 0 : t); }
};
struct ProbMoeDown8 {
    static constexpr bool GATHER = false; static constexpr int ESZ = 1;
    const unsigned char* A; int lda; const unsigned char* Bt; int ldb; int K; size_t estride; const int* tex; int sa, sb;
    __device__ __forceinline__ const char* a_tile(const Unit& u) const { return (const char*)(A + (size_t)u.pm * BM * lda); }
    __device__ __forceinline__ const char* b_tile(const Unit& u) const { const int e = __builtin_amdgcn_readfirstlane(tex[u.pm]); return (const char*)(Bt + (size_t)e * estride + (size_t)u.pn * BM * ldb); }
    __device__ __forceinline__ unsigned a_row(const Unit&, int r) const { return (unsigned)r; }
};
template <class P> __device__ __forceinline__ int prob_sa(const P& p) { if constexpr (P::ESZ == 1) return p.sa; else return 0; }
template <class P> __device__ __forceinline__ int prob_sb(const P& p) { if constexpr (P::ESZ == 1) return p.sb; else return 0; }

struct EpiBf16M {
    static constexpr bool PERM = true;
    bf16_t* O; int ldc; int mode; const bf16_t* aux1; int ld1; const bf16_t* aux2; int ld2;
    __device__ __forceinline__ void operator()(const f32x4 (&acc)[2][2][4][2], const Unit& u, int wr, int wc, int fr, int fq) const {
        const int row0 = u.pm * BM + wr * 64 + fr, col0 = u.pn * BM + wc * 32 + 8 * fq;
#pragma unroll
        for (int ai = 0; ai < 2; ++ai)
#pragma unroll
            for (int m = 0; m < 4; ++m) { const size_t row = (size_t)(row0 + ai * HALF + m * 16);
                float rsc = 1.f; if (mode == 6) { const f32x2_t q = *(const f32x2_t*)((const float*)aux1 + row * 4); rsc = 1.0f / sqrtf((q[0] + q[1]) * (1.f / 512) + EPS); }
#pragma unroll
                for (int bj = 0; bj < 2; ++bj) { const int col = col0 + bj * HALF;
                    float v[8];
#pragma unroll
                    for (int j = 0; j < 4; ++j) { v[j] = acc[ai][bj][m][0][j] * rsc; v[4 + j] = acc[ai][bj][m][1][j] * rsc; }
                    if (mode == 1) {
#pragma unroll
                        for (int j = 0; j < 8; ++j) v[j] = sigmoid_f(v[j]);
                    } else if (mode == 2 || mode == 3) {
                        float g[8]; unpack8(*(const u32x4*)(aux1 + row * ld1 + col), g);
#pragma unroll
                        for (int j = 0; j < 8; ++j) v[j] *= g[j];
                        if (mode == 3) { float a[8]; unpack8(*(const u32x4*)(aux2 + row * ld2 + col), a);
#pragma unroll
                            for (int j = 0; j < 8; ++j) v[j] += a[j]; }
                    }
                    *(u32x4*)(O + row * ldc + col) = pack8(v); }
                asm volatile("" ::: "memory"); }
    }
};
struct EpiBf16G {
    static constexpr bool PERM = true;
    bf16_t* O; int ldc; int gmode; int pn_lo, pn_hi; const float* gain; PG8_LAS float* P;
    float* ssq; int k8; unsigned char* c8;
    __device__ __forceinline__ void operator()(const f32x4 (&acc)[2][2][4][2], const Unit& u, int wr, int wc, int fr, int fq) const {
        const int row0 = u.pm * BM + wr * 64 + fr, col0 = u.pn * BM + wc * 32 + 8 * fq;
        const bool normed = (gmode == 5) || (u.pn >= pn_lo && u.pn < pn_hi);
        const bool stat_only = (gmode == 7);
        if (normed) {
#pragma unroll
            for (int ai = 0; ai < 2; ++ai)
#pragma unroll
                for (int m = 0; m < 4; ++m)
#pragma unroll
                    for (int bj = 0; bj < 2; ++bj) { float s = 0.f;
#pragma unroll
                        for (int n = 0; n < 2; ++n)
#pragma unroll
                            for (int j = 0; j < 4; ++j) s += acc[ai][bj][m][n][j] * acc[ai][bj][m][n][j];
                        s += xshfl<16>(s); { auto rr = __builtin_amdgcn_permlane32_swap(__float_as_uint(s), __float_as_uint(s), false, false); s = __uint_as_float(rr[0]) + __uint_as_float(rr[1]); }
                        if (fq == 0) P[(ai * HALF + wr * 64 + m * 16 + fr) * 8 + bj * 4 + wc] = s; }
            asm volatile("s_waitcnt lgkmcnt(0)\n\ts_barrier" ::: "memory");
        }
        float g0[8];
        { const int gc = (gmode == 5) ? wc * 32 + 8 * fq : (wc & 1) * 32 + 8 * fq;
#pragma unroll
            for (int k = 0; k < 8; ++k) g0[k] = (normed && !stat_only) ? gain[gc + k] : 1.f; }
#pragma unroll
        for (int ai = 0; ai < 2; ++ai)
#pragma unroll
            for (int m = 0; m < 4; ++m) { const size_t row = (size_t)(row0 + ai * HALF + m * 16); const int rl = ai * HALF + wr * 64 + m * 16 + fr;
                float rs[2] = {1.f, 1.f}; bool nb[2] = {false, false};
                if (normed && stat_only) { if (wc == 0 && fq == 0) { const f32x4 a = *(const PG8_LAS f32x4*)(P + rl * 8), b = *(const PG8_LAS f32x4*)(P + rl * 8 + 4); ssq[row * 4 + u.pn] = ((a[0] + a[1]) + (a[2] + a[3])) + ((b[0] + b[1]) + (b[2] + b[3])); } }
                else if (normed) {
                    if (gmode == 5) { const f32x4 a = *(const PG8_LAS f32x4*)(P + rl * 8); float rsc = 1.f, rsc2 = 1.f;
                        if (ssq) { rsc2 = 1.0f / (ssq[row * 4 + 2] * (1.f / 256) + EPS); rsc = sqrtf(rsc2); }
                        rs[0] = rsc / sqrtf(((a[0] + a[1]) + (a[2] + a[3])) * rsc2 * (1.f / 128) + EPS); rs[1] = rsc; nb[0] = true; nb[1] = (ssq != nullptr); }
                    else { const f32x2_t a = *(const PG8_LAS f32x2_t*)(P + rl * 8 + (wc & 2)), b = *(const PG8_LAS f32x2_t*)(P + rl * 8 + 4 + (wc & 2));
                        rs[0] = 1.0f / sqrtf((a[0] + a[1]) * (1.f / 64) + EPS); rs[1] = 1.0f / sqrtf((b[0] + b[1]) * (1.f / 64) + EPS); nb[0] = true; nb[1] = true; } }
#pragma unroll
                for (int bj = 0; bj < 2; ++bj) { const int col = col0 + bj * HALF;
                    float v[8];
#pragma unroll
                    for (int j = 0; j < 4; ++j) { v[j] = acc[ai][bj][m][0][j]; v[4 + j] = acc[ai][bj][m][1][j]; }
                    if (nb[bj]) { const bool ug = !(gmode == 5 && bj == 1);
#pragma unroll
                        for (int k = 0; k < 8; ++k) v[k] *= ug ? rs[bj] * g0[k] : rs[bj]; }
                    if (gmode == 7 && c8) { u32x2 w; w.x = pk4_fp8(v[0], v[1], v[2], v[3]); w.y = pk4_fp8(v[4], v[5], v[6], v[7]); *(u32x2*)(c8 + row * 1024 + col) = w; }
                    if (gmode == 5 && k8 && bj == 0) { u32x2 w; w.x = pk4_fp8(MLA_SQS * v[0], MLA_SQS * v[1], MLA_SQS * v[2], MLA_SQS * v[3]); w.y = pk4_fp8(MLA_SQS * v[4], MLA_SQS * v[5], MLA_SQS * v[6], MLA_SQS * v[7]); *(u32x2*)((unsigned char*)(O + row * ldc + u.pn * BM) + wc * 32 + 8 * fq) = w; }
                    else if (!(gmode == 7 && c8 && u.pn < 3)) *(u32x4*)(O + row * ldc + col) = pack8(v); }
                asm volatile("" ::: "memory"); }
    }
};
struct EpiSwiGLU {
    static constexpr bool PERM = true;
    bf16_t* O; int ldc;
    __device__ __forceinline__ void operator()(const f32x4 (&acc)[2][2][4][2], const Unit& u, int wr, int wc, int fr, int fq) const {
        const int row0 = u.pm * BM + wr * 64 + fr, col0 = u.pn * HALF + wc * 32 + 8 * fq;
#pragma unroll
        for (int ai = 0; ai < 2; ++ai)
#pragma unroll
            for (int m = 0; m < 4; ++m) { const size_t row = (size_t)(row0 + ai * HALF + m * 16);
                float v[8];
#pragma unroll
                for (int j = 0; j < 4; ++j) { const float g0 = acc[ai][0][m][0][j], g1 = acc[ai][0][m][1][j];
                    v[j] = g0 * sigmoid_f(g0) * acc[ai][1][m][0][j]; v[4 + j] = g1 * sigmoid_f(g1) * acc[ai][1][m][1][j]; }
                *(u32x4*)(O + row * ldc + col0) = pack8(v);
                asm volatile("" ::: "memory"); }
    }
};
struct EpiSwiGLU8 {
    static constexpr bool PERM = true;
    unsigned char* O; int ldc;
    __device__ __forceinline__ void operator()(const f32x4 (&acc)[2][2][4][2], const Unit& u, int wr, int wc, int fr, int fq) const {
        const int row0 = u.pm * BM + wr * 64 + fr, col0 = u.pn * HALF + wc * 32 + 8 * fq;
#pragma unroll
        for (int ai = 0; ai < 2; ++ai)
#pragma unroll
            for (int m = 0; m < 4; ++m) { const size_t row = (size_t)(row0 + ai * HALF + m * 16);
                float v[8];
#pragma unroll
                for (int j = 0; j < 4; ++j) { const float g0 = acc[ai][0][m][0][j], g1 = acc[ai][0][m][1][j];
                    v[j] = 4.0f * g0 * sigmoid_f(g0) * acc[ai][1][m][0][j]; v[4 + j] = 4.0f * g1 * sigmoid_f(g1) * acc[ai][1][m][1][j]; }
                u32x2 w; w.x = pk4_fp8(v[0], v[1], v[2], v[3]); w.y = pk4_fp8(v[4], v[5], v[6], v[7]);
                *(u32x2*)(O + row * ldc + col0) = w;
                asm volatile("" ::: "memory"); }
    }
};
struct EpiF32Res {
    static constexpr bool PERM = false;
    const float* base; float* out; int ldc;
    __device__ __forceinline__ void operator()(const f32x4 (&acc)[2][2][4][2], const Unit& u, int wr, int wc, int fr, int fq) const {
        const int row0 = u.pm * BM + wr * 64 + fr, col0 = u.pn * BM + wc * 32 + 4 * fq;
#pragma unroll
        for (int ai = 0; ai < 2; ++ai)
#pragma unroll
            for (int m = 0; m < 4; ++m) { const size_t off = (size_t)(row0 + ai * HALF + m * 16) * ldc + col0;
#pragma unroll
                for (int bj = 0; bj < 2; ++bj)
#pragma unroll
                    for (int n = 0; n < 2; ++n) { const f32x4 b = *(const f32x4*)(base + off + bj * HALF + n * 16); *(f32x4*)(out + off + bj * HALF + n * 16) = b + acc[ai][bj][m][n]; }
                asm volatile("" ::: "memory"); }
    }
};
struct EpiMoeDown {
    static constexpr bool PERM = false;
    float* out; int ldc; const int* tok; const float* wt;
    __device__ __forceinline__ void operator()(const f32x4 (&acc)[2][2][4][2], const Unit& u, int wr, int wc, int fr, int fq) const {
        const int row0 = u.pm * BM + wr * 64 + fr, col0 = u.pn * BM + wc * 32 + 4 * fq;
#pragma unroll
        for (int ai = 0; ai < 2; ++ai)
#pragma unroll
            for (int m = 0; m < 4; ++m) { const int r = row0 + ai * HALF + m * 16; const int t = tok[r]; const float w = wt[r];
                if (t >= 0) { float* rowp = out + (size_t)t * ldc + col0;
#pragma unroll
                    for (int bj = 0; bj < 2; ++bj)
#pragma unroll
                        for (int n = 0; n < 2; ++n) { const f32x4 b = *(const f32x4*)(rowp + bj * HALF + n * 16); *(f32x4*)(rowp + bj * HALF + n * 16) = b + w * acc[ai][bj][m][n]; } }
                asm volatile("" ::: "memory"); }
    }
};

template <class Prob, class Epi, class Sched>
__device__ __forceinline__ void gemm_phase(PG8_LAS unsigned char* lds, const Prob& P, const Sched& S, const Epi& E, const int tid_in) {
    int tid_ = tid_in; asm volatile("" : "+v"(tid_));
    const int tid = tid_, wid = __builtin_amdgcn_readfirstlane(tid >> 6), lane = tid & 63, wr = wid >> 2, wc = wid & 3, fr = lane & 15, fq = lane >> 4;
    constexpr int ESZ = Prob::ESZ;
    const int K = P.K, nt = K / (128 / ESZ); const int sca = prob_sa(P), scb = prob_sb(P); (void)sca; (void)scb;
    int sR[2], sC[2]; unsigned voffA[2], voffB[2];
#pragma unroll
    for (int i = 0; i < 2; ++i) { int R, C; stage_rc(tid * 16 + i * 8192, R, C); sR[i] = R; sC[i] = C; const int Rb = Epi::PERM ? ((R & ~31) + perm32(R & 31)) : R;
        voffA[i] = (unsigned)(R * P.lda) * (unsigned)ESZ + (unsigned)C * 2u; voffB[i] = (unsigned)(Rb * P.ldb) * (unsigned)ESZ + (unsigned)C * 2u; }
    const size_t kstep = (size_t)(BK * 2);
    const size_t hstepA = (size_t)HALF * P.lda * ESZ, hstepB = (size_t)HALF * P.ldb * ESZ;
    const unsigned ldsw = (unsigned)wid * 1024u;
    const int aoff = lds_byte(wr * 64 + fr, fq * 8), boff = lds_byte(wc * 32 + fr, fq * 8);
#define PG8_SA(b, h) (((b) * 2 + (h)) * HTB)
#define PG8_SB(b, h) ((4 + (b) * 2 + (h)) * HTB)
#define PG8_STAGE2(bufoff, gbase, v0, v1) do { \
        __builtin_amdgcn_global_load_lds((const unsigned*)((const char*)(gbase) + (v0)), (PG8_LAS unsigned*)(lds + (bufoff) + ldsw), 16, 0, 0); \
        __builtin_amdgcn_global_load_lds((const unsigned*)((const char*)(gbase) + (v1)), (PG8_LAS unsigned*)(lds + (bufoff) + ldsw + 8192), 16, 0, 0); } while (0)
#define PG8_STAGEB(bufoff, gbase) PG8_STAGE2(bufoff, gbase, voffB[0], voffB[1])
#define PG8_AOFF(h, i, nx) (Prob::GATHER ? ((nx) ? nvo[h][i] : cvo[h][i]) : voffA[i])
#define PG8_STAGEA(bufoff, gbase, h, nx) PG8_STAGE2(bufoff, (Prob::GATHER ? (gbase) : (gbase) + (h) * hstepA), PG8_AOFF(h, 0, nx), PG8_AOFF(h, 1, nx))
#define PG8_LDA(dst, b, h) do { if constexpr (ESZ == 2) { _Pragma("unroll") for (int m = 0; m < 4; ++m) _Pragma("unroll") for (int k = 0; k < 2; ++k) dst[m][k] = *(const PG8_LAS bf16x8*)(lds + PG8_SA(b, h) + aoff + m * 2048 + k * 1024); } \
    else { _Pragma("unroll") for (int m = 0; m < 4; ++m) dst##8[m] = __builtin_shufflevector(*(const PG8_LAS u32x4*)(lds + PG8_SA(b, h) + aoff + m * 2048), *(const PG8_LAS u32x4*)(lds + PG8_SA(b, h) + aoff + m * 2048 + 1024), 0, 1, 2, 3, 4, 5, 6, 7); } } while (0)
#define PG8_LDB(dst, b, h) do { if constexpr (ESZ == 2) { _Pragma("unroll") for (int n = 0; n < 2; ++n) _Pragma("unroll") for (int k = 0; k < 2; ++k) dst[n][k] = *(const PG8_LAS bf16x8*)(lds + PG8_SB(b, h) + boff + n * 2048 + k * 1024); } \
    else { _Pragma("unroll") for (int n = 0; n < 2; ++n) dst##8[n] = __builtin_shufflevector(*(const PG8_LAS u32x4*)(lds + PG8_SB(b, h) + boff + n * 2048), *(const PG8_LAS u32x4*)(lds + PG8_SB(b, h) + boff + n * 2048 + 1024), 0, 1, 2, 3, 4, 5, 6, 7); } } while (0)
#define PG8_MMA(ai, bj, At, Bt) do { __builtin_amdgcn_s_setprio(1); \
        if constexpr (ESZ == 2) { _Pragma("unroll") for (int m = 0; m < 4; ++m) _Pragma("unroll") for (int n = 0; n < 2; ++n) _Pragma("unroll") for (int k = 0; k < 2; ++k) \
            acc[ai][bj][m][n] = __builtin_amdgcn_mfma_f32_16x16x32_bf16(Bt[n][k], At[m][k], acc[ai][bj][m][n], 0, 0, 0); } \
        else { _Pragma("unroll") for (int m = 0; m < 4; ++m) _Pragma("unroll") for (int n = 0; n < 2; ++n) \
            asm volatile("v_mfma_scale_f32_16x16x128_f8f6f4 %0, %1, %2, %0, %3, %4 op_sel_hi:[0,0,0]" : "+v"(acc[ai][bj][m][n]) : "v"(Bt##8[n]), "v"(At##8[m]), "v"(scb), "v"(sca)); } \
        __builtin_amdgcn_s_setprio(0); } while (0)
#define PG8_WAIT_V(n) asm volatile("s_waitcnt vmcnt(" #n ")" ::: "memory")
#define PG8_WAIT_L(n) asm volatile("s_waitcnt lgkmcnt(" #n ")" ::: "memory")
#define PG8_BAR __builtin_amdgcn_s_barrier()
#define PG8_SCHED __builtin_amdgcn_sched_barrier(0)
#define PG8_ROWS(dst, u) do { _Pragma("unroll") for (int h = 0; h < 2; ++h) _Pragma("unroll") for (int i = 0; i < 2; ++i) \
        dst[h][i] = P.a_row(u, h * HALF + sR[i]) * (unsigned)P.lda * (unsigned)ESZ + (unsigned)sC[i] * 2u; } while (0)
    Unit cur, nxt; int ui = 0;
    if (!S.next(0, cur)) return;
    f32x4 acc[2][2][4][2];
#pragma unroll
    for (int a = 0; a < 2; ++a)
#pragma unroll
        for (int b = 0; b < 2; ++b)
#pragma unroll
            for (int m = 0; m < 4; ++m)
#pragma unroll
                for (int n = 0; n < 2; ++n) acc[a][b][m][n] = (f32x4){0.f, 0.f, 0.f, 0.f};
    bf16x8 At[4][2], B0[2][2], B1[2][2]; typedef unsigned u32x8 __attribute__((ext_vector_type(8))); u32x8 At8[4], B08[2], B18[2];
    unsigned cvo[2][2], nvo[2][2];
    if constexpr (Prob::GATHER) { PG8_ROWS(cvo, cur);
#pragma unroll
        for (int h = 0; h < 2; ++h)
#pragma unroll
            for (int i = 0; i < 2; ++i) nvo[h][i] = cvo[h][i]; }
    const char* cA = P.a_tile(cur); const char* cB = P.b_tile(cur);
    PG8_STAGEB(PG8_SB(0, 0), cB); PG8_STAGEB(PG8_SB(0, 1), cB + hstepB); PG8_STAGEA(PG8_SA(0, 0), cA, 0, false); PG8_STAGEA(PG8_SA(0, 1), cA, 1, false);
    if (wr == 1) PG8_BAR;
    PG8_WAIT_V(2); PG8_BAR;
    PG8_STAGEB(PG8_SB(1, 0), cB + kstep); PG8_STAGEA(PG8_SA(1, 0), cA + kstep, 0, false); PG8_STAGEB(PG8_SB(1, 1), cB + hstepB + kstep);
    PG8_WAIT_V(6); PG8_BAR;
    for (;;) {
        const bool has_next = S.next(ui + 1, nxt);
        const char* nA = has_next ? P.a_tile(nxt) : cA; const char* nB = has_next ? P.b_tile(nxt) : cB;
        if constexpr (Prob::GATHER) { if (has_next) PG8_ROWS(nvo, nxt); }
        for (int t = 0; t < nt; t += 2) {
            const bool last = (t == nt - 2);
            const char* a1 = cA + (size_t)(t + 1) * kstep;
            const char* a2 = last ? nA : cA + (size_t)(t + 2) * kstep; const char* b2 = last ? nB : cB + (size_t)(t + 2) * kstep;
            const char* a3 = a2 + kstep; const char* b3 = b2 + kstep;
            const bool nx = Prob::GATHER ? last : false;
            PG8_LDB(B0, 0, 0); PG8_LDB(B1, 0, 1); PG8_SCHED; PG8_LDA(At, 0, 0); PG8_STAGEA(PG8_SA(1, 1), a1, 1, false);
            PG8_WAIT_V(8); PG8_WAIT_L(0); PG8_BAR; PG8_MMA(0, 0, At, B0); PG8_MMA(0, 1, At, B1); PG8_BAR; PG8_SCHED;
            PG8_LDA(At, 0, 1); PG8_STAGEB(PG8_SB(0, 0), b2); PG8_STAGEB(PG8_SB(0, 1), b2 + hstepB); PG8_STAGEA(PG8_SA(0, 0), a2, 0, nx);
            PG8_WAIT_V(8); PG8_WAIT_L(0); PG8_BAR; PG8_MMA(1, 0, At, B0); PG8_MMA(1, 1, At, B1); PG8_BAR; PG8_SCHED;
            PG8_LDB(B0, 1, 0); PG8_LDB(B1, 1, 1); PG8_SCHED; PG8_LDA(At, 1, 0); PG8_STAGEA(PG8_SA(0, 1), a2, 1, nx);
            PG8_WAIT_V(8); PG8_WAIT_L(0); PG8_BAR; PG8_MMA(0, 0, At, B0); PG8_MMA(0, 1, At, B1); PG8_BAR; PG8_SCHED;
            PG8_LDA(At, 1, 1); PG8_STAGEB(PG8_SB(1, 0), b3); PG8_STAGEB(PG8_SB(1, 1), b3 + hstepB); PG8_STAGEA(PG8_SA(1, 0), a3, 0, nx);
            PG8_WAIT_V(8); PG8_WAIT_L(0); PG8_BAR; PG8_MMA(1, 0, At, B0); PG8_MMA(1, 1, At, B1); PG8_BAR; PG8_SCHED;
        }
        if (wr == 0) PG8_BAR;
        if constexpr (ESZ == 1) asm volatile("s_nop 15\n\ts_nop 15\n\ts_nop 15" ::: "memory");
        E(acc, cur, wr, wc, fr, fq);
        if (!has_next) break;
#pragma unroll
        for (int a = 0; a < 2; ++a)
#pragma unroll
            for (int b = 0; b < 2; ++b)
#pragma unroll
                for (int m = 0; m < 4; ++m)
#pragma unroll
                    for (int n = 0; n < 2; ++n) acc[a][b][m][n] = (f32x4){0.f, 0.f, 0.f, 0.f};
        cur = nxt; cA = nA; cB = nB; ++ui;
        if constexpr (Prob::GATHER) {
#pragma unroll
            for (int h = 0; h < 2; ++h)
#pragma unroll
                for (int i = 0; i < 2; ++i) cvo[h][i] = nvo[h][i]; }
        if (wr == 1) PG8_BAR;
    }
    PG8_WAIT_V(0);
    PG8_BAR;
#undef PG8_SA
#undef PG8_SB
#undef PG8_STAGE2
#undef PG8_STAGEB
#undef PG8_STAGEA
#undef PG8_AOFF
#undef PG8_LDA
#undef PG8_LDB
#undef PG8_MMA
#undef PG8_WAIT_V
#undef PG8_WAIT_L
#undef PG8_BAR
#undef PG8_SCHED
#undef PG8_ROWS
}
}

namespace att {
constexpr int NW = 8, QBLK = 32, KVBLK = 64, DV = 128;
constexpr int SHM_V = KVBLK * DV * 2;
constexpr int OFF_V = 0, OFF_K = 2 * SHM_V;
constexpr int KB_MAX = KVBLK * 192 * 2;
constexpr int OFF_WS = OFF_K + 2 * KB_MAX, OFF_POS = OFF_WS + NW * 64 * 4, OFF_QR = OFF_POS + 2 * 64 * 4, LDS_BYTES = OFF_QR + NW * 4096;
constexpr float THR = 8.f;
typedef LAS char* lptr;
#define SBAR() __builtin_amdgcn_sched_barrier(0)
__device__ __forceinline__ int crow(int r, int hi) { return (r & 3) + 8 * (r >> 2) + 4 * hi; }
template <int DQK> __device__ __forceinline__ int kswz(int row, int c) { return row * (DQK * 2) + (((c & ~7) | ((c ^ (row >> 1)) & 7)) << 4); }
__device__ __forceinline__ int v_st(int k, int c) { const int kk = (k & ~0xC) | ((k & 4) << 1) | ((k & 8) >> 1); return ((kk >> 3) * 4 + (c >> 5)) * 512 + ((kk & 7) * 32 + (c & 31)) * 2; }
__device__ __forceinline__ int v_rd_base(int lane) { return ((lane & 3) << 3) | (((lane >> 2) & 3) << 6) | (((lane >> 4) & 1) << 5) | (((lane >> 5) & 1) << 8); }
constexpr int v_rd_off(int d0, int ks, int half) { return d0 * 512 + ks * 4096 + half * 2048; }
template <int OFF> __device__ __forceinline__ s16x4 tr_read(int vb) { s16x4 r; asm volatile("ds_read_b64_tr_b16 %0, %1 offset:%2" : "=&v"(r) : "v"(vb), "i"(OFF) : "memory"); return r; }

template <int D0> __device__ __forceinline__ void pv_one(f32x16& od, int vb, bf16x8 pa0, bf16x8 pa1, bf16x8 pa2, bf16x8 pa3) {
  const s16x4 l0 = tr_read<v_rd_off(D0, 0, 0)>(vb), h0 = tr_read<v_rd_off(D0, 0, 1)>(vb), l1 = tr_read<v_rd_off(D0, 1, 0)>(vb), h1 = tr_read<v_rd_off(D0, 1, 1)>(vb);
  const s16x4 l2 = tr_read<v_rd_off(D0, 2, 0)>(vb), h2 = tr_read<v_rd_off(D0, 2, 1)>(vb), l3 = tr_read<v_rd_off(D0, 3, 0)>(vb), h3 = tr_read<v_rd_off(D0, 3, 1)>(vb);
  asm volatile("s_waitcnt lgkmcnt(0)" ::: "memory"); SBAR();
#define PK(L, H) (bf16x8){L[0], L[1], L[2], L[3], H[0], H[1], H[2], H[3]}
  od = __builtin_amdgcn_mfma_f32_32x32x16_bf16(pa0, PK(l0, h0), od, 0, 0, 0);
  od = __builtin_amdgcn_mfma_f32_32x32x16_bf16(pa1, PK(l1, h1), od, 0, 0, 0);
  od = __builtin_amdgcn_mfma_f32_32x32x16_bf16(pa2, PK(l2, h2), od, 0, 0, 0);
  od = __builtin_amdgcn_mfma_f32_32x32x16_bf16(pa3, PK(l3, h3), od, 0, 0, 0);
#undef PK
}
__device__ __forceinline__ void pv_d0(f32x16* o, int vb, bf16x8 pa0, bf16x8 pa1, bf16x8 pa2, bf16x8 pa3) {
  pv_one<0>(o[0], vb, pa0, pa1, pa2, pa3); pv_one<1>(o[1], vb, pa0, pa1, pa2, pa3); pv_one<2>(o[2], vb, pa0, pa1, pa2, pa3); pv_one<3>(o[3], vb, pa0, pa1, pa2, pa3);
}

constexpr int D_OFF_V = 0, D_OFF_KN = 32768, D_OFF_KR = 65536, D_OFF_WS = 81920, D_OFF_POS = 83968, D_OFF_QX = 88064, D_OFF_TT = D_OFF_QX + 8 * 4096, D_LDS_BYTES = D_OFF_TT + 1024;
__device__ __forceinline__ const char* sgpr_ptr(const char* p) { const unsigned lo = __builtin_amdgcn_readfirstlane((unsigned)(uintptr_t)p), hi = __builtin_amdgcn_readfirstlane((unsigned)((uintptr_t)p >> 32)); return (const char*)(((uintptr_t)hi << 32) | lo); }
__device__ __forceinline__ void glds16(const char* g, unsigned voff, lptr l) { __builtin_amdgcn_global_load_lds((const unsigned*)(g + voff), (LAS unsigned*)l, 16, 0, 0); }
__device__ __forceinline__ void glds16s(const char* g, unsigned voff, lptr l) { const unsigned m = __builtin_amdgcn_readfirstlane((unsigned)(uintptr_t)l); const char* gs = sgpr_ptr(g);
  asm volatile("s_mov_b32 m0, %0\n\tglobal_load_lds_dwordx4 %1, %2" :: "s"(m), "v"(voff), "s"(gs) : "memory", "m0"); }
__device__ __forceinline__ void glds4s(const char* g, unsigned voff, lptr l) { const unsigned m = __builtin_amdgcn_readfirstlane((unsigned)(uintptr_t)l); const char* gs = sgpr_ptr(g);
  asm volatile("s_mov_b32 m0, %0\n\tglobal_load_lds_dword %1, %2" :: "s"(m), "v"(voff), "s"(gs) : "memory", "m0"); }
__device__ __forceinline__ void glds4(const char* g, unsigned voff, lptr l) { __builtin_amdgcn_global_load_lds((const unsigned*)(g + voff), (LAS unsigned*)l, 4, 0, 0); }
__device__ __forceinline__ void kpre64(bf16x8 (&kf)[8], f32x4 (&pkv)[8], const lptr Kr, const LAS float* pk, const bool alibi, int r32, int hi) {
  const lptr rr = Kr + r32 * 128; const int k8 = (r32 >> 1) & 7;
#pragma unroll
  for (int d0 = 0; d0 < 4; ++d0) { const int cs = (((2 * d0 + hi) ^ k8) & 7) << 4; kf[2 * d0] = *(const LAS bf16x8*)(rr + cs); kf[2 * d0 + 1] = *(const LAS bf16x8*)(rr + 4096 + cs); }
  if (alibi) {
#pragma unroll
    for (int g = 0; g < 4; ++g) { pkv[g] = *(const LAS f32x4*)(pk + 8 * g + 4 * hi); pkv[4 + g] = *(const LAS f32x4*)(pk + 32 + 8 * g + 4 * hi); } }
}
__device__ __forceinline__ void qkt64(f32x16& p0, f32x16& p1, const bf16x8 (&kf)[8], const bf16x8* qr, const f32x16& negm, const bool fold, const bf16x8 kext0, const bf16x8 kext1, const bf16x8 qext) {
  p0 = __builtin_amdgcn_mfma_f32_32x32x16_bf16(kf[0], qr[0], negm, 0, 0, 0); p1 = __builtin_amdgcn_mfma_f32_32x32x16_bf16(kf[1], qr[0], negm, 0, 0, 0);
#pragma unroll
  for (int d0 = 1; d0 < 4; ++d0) { p0 = __builtin_amdgcn_mfma_f32_32x32x16_bf16(kf[2 * d0], qr[d0], p0, 0, 0, 0); p1 = __builtin_amdgcn_mfma_f32_32x32x16_bf16(kf[2 * d0 + 1], qr[d0], p1, 0, 0, 0); }
  if (fold) { p0 = __builtin_amdgcn_mfma_f32_32x32x16_bf16(kext0, qext, p0, 0, 0, 0); p1 = __builtin_amdgcn_mfma_f32_32x32x16_bf16(kext1, qext, p1, 0, 0, 0); }
}
template <int DQK>
__device__ __forceinline__ void qkt_d(f32x16& p0, f32x16& p1, const lptr Kn, const lptr Kr, const bf16x8* qr, const lptr qx, const f32x16& negm, int r32, int hi) {
  const lptr rn = Kn + r32 * 256, rr = Kr + r32 * 128; const int k16 = r32 & 15, k8 = (r32 >> 1) & 7;
#pragma unroll
  for (int d0 = 0; d0 < DQK / 16; ++d0) {
    bf16x8 b0, b1;
    if (DQK == 192 && d0 < 8) { const int cs = ((2 * d0 + hi) ^ k16) << 4; b0 = *(const LAS bf16x8*)(rn + cs); b1 = *(const LAS bf16x8*)(rn + 8192 + cs); }
    else { const int cr = (DQK == 192) ? 2 * (d0 - 8) + hi : 2 * d0 + hi; const int cs = ((cr ^ k8) & 7) << 4; b0 = *(const LAS bf16x8*)(rr + cs); b1 = *(const LAS bf16x8*)(rr + 4096 + cs); }
    bf16x8 q;
    if (d0 < 8) q = qr[d0 < 8 ? d0 : 0]; else q = *(const LAS bf16x8*)(qx + r32 * 128 + ((((2 * (d0 - 8) + hi) ^ k8) & 7) << 4));
    if (d0 == 0) { p0 = __builtin_amdgcn_mfma_f32_32x32x16_bf16(b0, q, negm, 0, 0, 0); p1 = __builtin_amdgcn_mfma_f32_32x32x16_bf16(b1, q, negm, 0, 0, 0); }
    else { p0 = __builtin_amdgcn_mfma_f32_32x32x16_bf16(b0, q, p0, 0, 0, 0); p1 = __builtin_amdgcn_mfma_f32_32x32x16_bf16(b1, q, p1, 0, 0, 0); } }
}
#define MX3(a, b, c) __builtin_fmaxf(__builtin_fmaxf((a), (b)), (c))
template <bool ALIBI, bool FIRST>
__device__ __forceinline__ void softmax_a(f32x16& p0, f32x16& p1, float& mhat, f32x16& negm, float& l_reg, float& alpha, const f32x4 (&pkv)[8], const float pq, const float nsl2) {
  constexpr float THRL = 11.0f;
  if constexpr (ALIBI) {
#pragma unroll
    for (int g = 0; g < 4; ++g) { const f32x4 a = pkv[g], b = pkv[4 + g];
#pragma unroll
      for (int j = 0; j < 4; ++j) { p0[4 * g + j] = fmaf(fabsf(a[j] - pq), nsl2, p0[4 * g + j]); p1[4 * g + j] = fmaf(fabsf(b[j] - pq), nsl2, p1[4 * g + j]); } }
  }
  float a = MX3(p0[0], p0[1], p1[0]), b = MX3(p0[2], p0[3], p1[1]); a = MX3(a, p1[2], p1[3]);
#pragma unroll
  for (int r = 4; r < 16; r += 4) { a = MX3(a, p0[r], p0[r + 1]); b = MX3(b, p0[r + 2], p0[r + 3]); a = MX3(a, p1[r], p1[r + 1]); b = MX3(b, p1[r + 2], p1[r + 3]); }
  float rm = fmaxf(a, b);
  { auto rr = __builtin_amdgcn_permlane32_swap(__float_as_uint(rm), __float_as_uint(rm), false, false); rm = fmaxf(__uint_as_float(rr[0]), __uint_as_float(rr[1])); }
  alpha = 1.f;
  if (FIRST || __builtin_expect(__any(rm > THRL), 0)) { const float dl = FIRST ? rm : fmaxf(rm, 0.f); mhat += dl;
#pragma unroll
    for (int r = 0; r < 16; ++r) { p0[r] -= dl; p1[r] -= dl; }
#pragma unroll
    for (int r = 0; r < 16; ++r) negm[r] = -mhat;
    asm volatile("" : "+v"(negm));
    if (!FIRST) { alpha = __builtin_amdgcn_exp2f(-dl); l_reg *= alpha; } }
#pragma unroll
  for (int r = 0; r < 16; ++r) p0[r] = __builtin_amdgcn_exp2f(p0[r]);
}
__device__ __forceinline__ void softmax_b(f32x16& p0, f32x16& p1, float& l_reg, bf16x8& pa0, bf16x8& pa1, bf16x8& pa2, bf16x8& pa3) {
#pragma unroll
  for (int r = 0; r < 16; ++r) p1[r] = __builtin_amdgcn_exp2f(p1[r]);
  float ps = 0;
#pragma unroll
  for (int r = 0; r < 16; ++r) ps += p0[r];
#pragma unroll
  for (int r = 0; r < 16; ++r) ps += p1[r];
  { auto rr = __builtin_amdgcn_permlane32_swap(__float_as_uint(ps), __float_as_uint(ps), false, false); ps = __uint_as_float(rr[0]) + __uint_as_float(rr[1]); }
  l_reg += ps;
#define PK4(P, BASE, OUT) do { unsigned a0 = cvt_pk_bf16(P[BASE + 0], P[BASE + 1]), a1 = cvt_pk_bf16(P[BASE + 2], P[BASE + 3]);   \
    unsigned b0 = cvt_pk_bf16(P[BASE + 4], P[BASE + 5]), b1 = cvt_pk_bf16(P[BASE + 6], P[BASE + 7]);                              \
    auto r0 = __builtin_amdgcn_permlane32_swap(a0, b0, false, false); auto r1 = __builtin_amdgcn_permlane32_swap(a1, b1, false, false); \
    u32x4 w = {r0[0], r1[0], r0[1], r1[1]}; OUT = __builtin_bit_cast(bf16x8, w); } while (0)
  PK4(p0, 0, pa0); PK4(p0, 8, pa1); PK4(p1, 0, pa2); PK4(p1, 8, pa3);
#undef PK4
}
template <bool ALIBI, bool NOMAX = false>
__device__ __forceinline__ void sm_chunk(f32x16& p0, f32x16& p1, float& mx, const int g, const LAS float* pk, const int hi, const float pq, const float nsl2, const bool fold) {
  if (ALIBI && !fold) { const f32x4 a = *(const LAS f32x4*)(pk + 8 * g + 4 * hi), b = *(const LAS f32x4*)(pk + 32 + 8 * g + 4 * hi);
#pragma unroll
    for (int j = 0; j < 4; ++j) { p0[4 * g + j] = fmaf(fabsf(a[j] - pq), nsl2, p0[4 * g + j]); p1[4 * g + j] = fmaf(fabsf(b[j] - pq), nsl2, p1[4 * g + j]); } }
  if constexpr (!NOMAX) { mx = MX3(mx, p0[4 * g], p0[4 * g + 1]); mx = MX3(mx, p0[4 * g + 2], p0[4 * g + 3]); mx = MX3(mx, p1[4 * g], p1[4 * g + 1]); mx = MX3(mx, p1[4 * g + 2], p1[4 * g + 3]); }
}
template <bool FIRST>
__device__ __forceinline__ void sm_tail(f32x16& p0, f32x16& p1, float rm, float& mhat, f32x16& negm, float& l_reg, float& alpha) {
  constexpr float THRL = 11.0f;
  { auto rr = __builtin_amdgcn_permlane32_swap(__float_as_uint(rm), __float_as_uint(rm), false, false); rm = fmaxf(__uint_as_float(rr[0]), __uint_as_float(rr[1])); }
  alpha = 1.f;
  if (FIRST || __builtin_expect(__any(rm > THRL), 0)) { const float dl = FIRST ? rm : fmaxf(rm, 0.f); mhat += dl;
#pragma unroll
    for (int r = 0; r < 16; ++r) { p0[r] -= dl; p1[r] -= dl; }
#pragma unroll
    for (int r = 0; r < 16; ++r) negm[r] = -mhat;
    asm volatile("" : "+v"(negm));
    if (!FIRST) { alpha = __builtin_amdgcn_exp2f(-dl); l_reg *= alpha; } }
#pragma unroll
  for (int r = 0; r < 16; ++r) p0[r] = __builtin_amdgcn_exp2f(p0[r]);
}
__device__ __forceinline__ void sm_exp1(f32x16& p1) {
#pragma unroll
  for (int r = 0; r < 16; ++r) p1[r] = __builtin_amdgcn_exp2f(p1[r]);
}
__device__ __forceinline__ void sm_sumpack(f32x16& p0, f32x16& p1, float& l_reg, bf16x8& pa0, bf16x8& pa1, bf16x8& pa2, bf16x8& pa3) {
  float ps = 0;
#pragma unroll
  for (int r = 0; r < 16; ++r) ps += p0[r];
#pragma unroll
  for (int r = 0; r < 16; ++r) ps += p1[r];
  { auto rr = __builtin_amdgcn_permlane32_swap(__float_as_uint(ps), __float_as_uint(ps), false, false); ps = __uint_as_float(rr[0]) + __uint_as_float(rr[1]); }
  l_reg += ps;
#define PK4(P, BASE, OUT) do { unsigned a0 = cvt_pk_bf16(P[BASE + 0], P[BASE + 1]), a1 = cvt_pk_bf16(P[BASE + 2], P[BASE + 3]);   \
    unsigned b0 = cvt_pk_bf16(P[BASE + 4], P[BASE + 5]), b1 = cvt_pk_bf16(P[BASE + 6], P[BASE + 7]);                              \
    auto r0 = __builtin_amdgcn_permlane32_swap(a0, b0, false, false); auto r1 = __builtin_amdgcn_permlane32_swap(a1, b1, false, false); \
    u32x4 w = {r0[0], r1[0], r0[1], r1[1]}; OUT = __builtin_bit_cast(bf16x8, w); } while (0)
  PK4(p0, 0, pa0); PK4(p0, 8, pa1); PK4(p1, 0, pa2); PK4(p1, 8, pa3);
#undef PK4
}
template <bool ALIBI, int D0, bool NOMAX = false>
__device__ __forceinline__ void pv_sm_one(f32x16& od, int vb, bf16x8 pa0, bf16x8 pa1, bf16x8 pa2, bf16x8 pa3, f32x16& x0, f32x16& x1, float& mx, const LAS float* pk, const int hi, const float pq, const float nsl2, const bool fold) {
  const s16x4 l0 = tr_read<v_rd_off(D0, 0, 0)>(vb), h0 = tr_read<v_rd_off(D0, 0, 1)>(vb), l1 = tr_read<v_rd_off(D0, 1, 0)>(vb), h1 = tr_read<v_rd_off(D0, 1, 1)>(vb);
  const s16x4 l2 = tr_read<v_rd_off(D0, 2, 0)>(vb), h2 = tr_read<v_rd_off(D0, 2, 1)>(vb), l3 = tr_read<v_rd_off(D0, 3, 0)>(vb), h3 = tr_read<v_rd_off(D0, 3, 1)>(vb);
  SBAR(); sm_chunk<ALIBI, NOMAX>(x0, x1, mx, D0, pk, hi, pq, nsl2, fold); SBAR();
  asm volatile("s_waitcnt lgkmcnt(0)" ::: "memory"); SBAR();
#define PK(L, H) (bf16x8){L[0], L[1], L[2], L[3], H[0], H[1], H[2], H[3]}
  od = __builtin_amdgcn_mfma_f32_32x32x16_bf16(pa0, PK(l0, h0), od, 0, 0, 0);
  od = __builtin_amdgcn_mfma_f32_32x32x16_bf16(pa1, PK(l1, h1), od, 0, 0, 0);
  od = __builtin_amdgcn_mfma_f32_32x32x16_bf16(pa2, PK(l2, h2), od, 0, 0, 0);
  od = __builtin_amdgcn_mfma_f32_32x32x16_bf16(pa3, PK(l3, h3), od, 0, 0, 0);
#undef PK
}
template <int DQK, bool ALIBI, int EPI = 0, bool FIXREF = false>
__device__ __forceinline__ void attn_unit_dma(const bf16* __restrict__ Qb, int ldq, const bf16* __restrict__ Kh, int ldk, const bf16* __restrict__ KRh, const bf16* __restrict__ Vh, int ldv,
                                              bf16* __restrict__ Ob, int ldo, const float* __restrict__ posq, const float* __restrict__ posk, const float nsl, const float scale, const int seq, const lptr lds, const int wave_s,
                                              const float* __restrict__ gq1, const float* __restrict__ gq2, const float* __restrict__ ropeq, const LAS int* tcls, const LAS float* tp0, const float* __restrict__ gsub = nullptr, const float lam = 0.f, const float omli = 0.f) {
  constexpr int ND = DQK / 16;
  const int tid = fresh_tid(wave_s), lane = tid & 63, r32 = lane & 31, hi = lane >> 5; const int wid = __builtin_amdgcn_readfirstlane(tid >> 6);
  LAS float* wsf = (LAS float*)(lds + D_OFF_WS) + wid * 64; LAS float* al_l = wsf + 32;
  LAS float* pos_l = (LAS float*)(lds + D_OFF_POS + wid * 512);
  (void)scale;
  unsigned kno[2], vo[2], kro;
#pragma unroll
  for (int i = 0; i < 2; ++i) { const int p = 2 * wid + i;
    { const int row = 4 * p + (lane >> 4), c = (lane & 15) ^ (row & 15); kno[i] = (unsigned)(row * ldk + c * 8) * 2u; }
    { const int st = 2 * p + (lane >> 5), w = lane & 31, kk = (st >> 2) * 8 + (w >> 2), k = (kk & ~0xC) | ((kk & 4) << 1) | ((kk & 8) >> 1), c = (st & 3) * 32 + (w & 3) * 8; vo[i] = (unsigned)(k * ldv + c) * 2u; } }
  { const int row = 8 * wid + (lane >> 3), c = (lane & 7) ^ ((row >> 1) & 7); kro = (DQK == 192) ? (unsigned)(row * 64 + c * 8) * 2u : (unsigned)(row * ldk + c * 8) * 2u; }
  const unsigned pso = (unsigned)lane * 4u;
  const lptr vdst = lds + D_OFF_V + wid * 2048, kndst = lds + D_OFF_KN + wid * 2048, krdst = lds + D_OFF_KR + wid * 1024;
#define DMA_K(t, s) do { if constexpr (DQK == 192) { const char* kb_ = (const char*)Kh + (size_t)(t) * (KVBLK * 2) * ldk; glds16s(kb_, kno[0], kndst + (s) * 16384); glds16s(kb_, kno[1], kndst + (s) * 16384 + 1024); \
      glds16s((const char*)KRh + (size_t)(t) * (KVBLK * 128), kro, krdst + (s) * 8192); } \
    else { glds16s((const char*)Kh + (size_t)(t) * (KVBLK * 2) * ldk, kro, krdst + (s) * 8192); } \
    if constexpr (ALIBI) glds4s((const char*)posk + (size_t)(t) * (KVBLK * 4), pso, (lptr)pos_l + (s) * 256); } while (0)
#define DMA_V(t, s) do { const char* vb_ = (const char*)Vh + (size_t)(t) * (KVBLK * 2) * ldv; glds16s(vb_, vo[0], vdst + (s) * 16384); glds16s(vb_, vo[1], vdst + (s) * 16384 + 1024); } while (0)
#define WAITBAR() asm volatile("s_waitcnt vmcnt(0) lgkmcnt(0)\n\ts_barrier" ::: "memory")
#define RESC(a) do { if (__any((a) < 1.f)) { if (hi == 0) al_l[r32] = (a); asm volatile("s_waitcnt lgkmcnt(0)" ::: "memory"); \
    _Pragma("unroll") for (int d = 0; d < 4; ++d) _Pragma("unroll") for (int r = 0; r < 16; ++r) o[d][r] *= al_l[crow(r, hi)]; } } while (0)
  const int NT = seq / KVBLK;
  DMA_K(0, 0); DMA_V(0, 0); DMA_K(1, 1);
  constexpr int NQR = ND < 8 ? ND : 8;
  float mhat = 0.f, l_reg = 0; f32x16 o[4] = {}; bf16x8 qr[NQR]; f32x16 negm = f32x16{}; if constexpr (!FIXREF) asm volatile("" : "+v"(negm));
  const bf16* Qw = Qb + (long)(wid * QBLK + r32) * ldq + hi * 8;
  const lptr qx = lds + D_OFF_QX + wid * 4096;
  { bf16x8 qv[ND];
#pragma unroll
    for (int d0 = 0; d0 < ND; ++d0) qv[d0] = *(const bf16x8*)(Qw + d0 * 16);
    constexpr int NN = (DQK == 192) ? 8 : 4;
    constexpr float QS = (DQK == 192) ? 0.07216878364870322f * 1.4426950408889634f : 0.125f * 1.4426950408889634f;
    float ssn = 0.f;
#pragma unroll
    for (int d0 = 0; d0 < NN; ++d0) { float f[8]; unpack8(__builtin_bit_cast(u32x4, qv[d0]), f); ssn += ssq8(f); }
    { auto rr = __builtin_amdgcn_permlane32_swap(__float_as_uint(ssn), __float_as_uint(ssn), false, false); ssn = __uint_as_float(rr[0]) + __uint_as_float(rr[1]); }
    const float rn = QS / sqrtf(ssn * (1.f / (16 * NN)) + EPS);
#pragma unroll
    for (int d0 = 0; d0 < NN; ++d0) { float f[8]; unpack8(__builtin_bit_cast(u32x4, qv[d0]), f); const f32x4 g0 = *(const f32x4*)(gq1 + 16 * d0 + 8 * hi), g1 = *(const f32x4*)(gq1 + 16 * d0 + 8 * hi + 4);
#pragma unroll
      for (int e = 0; e < 4; ++e) { f[e] *= rn * g0[e]; f[4 + e] *= rn * g1[e]; }
      qr[d0] = __builtin_bit_cast(bf16x8, pack8(f)); }
    if constexpr (DQK == 192) {
      float ssr = 0.f;
#pragma unroll
      for (int d0 = 8; d0 < 12; ++d0) { float f[8]; unpack8(__builtin_bit_cast(u32x4, qv[d0]), f); ssr += ssq8(f); }
      { auto rr = __builtin_amdgcn_permlane32_swap(__float_as_uint(ssr), __float_as_uint(ssr), false, false); ssr = __uint_as_float(rr[0]) + __uint_as_float(rr[1]); }
      const float rr_ = 1.0f / sqrtf(ssr * (1.f / ROPE) + EPS);
      const float* rp = ropeq + (size_t)(wid * QBLK + r32) * 64;
#pragma unroll
      for (int dd = 0; dd < 2; ++dd) { float x1[8], x2[8], o1[8], o2[8]; unpack8(__builtin_bit_cast(u32x4, qv[8 + dd]), x1); unpack8(__builtin_bit_cast(u32x4, qv[10 + dd]), x2);
        const int i0 = 16 * dd + 8 * hi;
#pragma unroll
        for (int e = 0; e < 8; ++e) { const float a = x1[e] * rr_ * gq2[i0 + e], b = x2[e] * rr_ * gq2[32 + i0 + e]; const float c = rp[2 * (i0 + e)], s = rp[2 * (i0 + e) + 1];
          o1[e] = (a * c - b * s) * QS; o2[e] = (b * c + a * s) * QS; }
        *(LAS u32x4*)(qx + r32 * 128 + ((((2 * dd + hi) ^ (r32 >> 1)) & 7) << 4)) = pack8(o1);
        *(LAS u32x4*)(qx + r32 * 128 + ((((2 * (dd + 2) + hi) ^ (r32 >> 1)) & 7) << 4)) = pack8(o2); } } }
  float pq = 0.f; if constexpr (ALIBI) pq = posq[wid * QBLK + r32];
  const int vb0 = (int)(unsigned)(uintptr_t)(lds + D_OFF_V) + v_rd_base(lane);
  const lptr Kn0 = lds + D_OFF_KN, Kr0 = lds + D_OFF_KR;
  f32x16 pA0, pA1, pB0, pB1; float alA, alB; bf16x8 pa0, pa1, pa2, pa3;
  WAITBAR();
  f32x4 pkv[8];
  bf16x8 kext0 = bf16x8{}, kext1 = bf16x8{}, qext = bf16x8{}; unsigned w0pos = 0u, s3b = 0u; float sp = 0.f;
  if constexpr (ALIBI && DQK == 64) { sp = -nsl;
    const unsigned s1b = cvt_pk_bf16(sp, 0.f) & 0xffffu; const float r1 = sp - __uint_as_float(s1b << 16); const unsigned s2b = cvt_pk_bf16(r1, 0.f) & 0xffffu; const float r2 = r1 - __uint_as_float(s2b << 16);
    s3b = cvt_pk_bf16(r2, 0.f) & 0xffffu; w0pos = s1b | (s2b << 16);
    const unsigned k0b = __float_as_uint((float)r32) >> 16, k1b = __float_as_uint((float)(32 + r32)) >> 16, one = 0x3F80u;
    const u32x4 e0 = {k0b | (k0b << 16), k0b | (one << 16), one | (one << 16), 0u}, e1 = {k1b | (k1b << 16), k1b | (one << 16), one | (one << 16), 0u}, z = {0u, 0u, 0u, 0u};
    kext0 = __builtin_bit_cast(bf16x8, hi ? z : e0); kext1 = __builtin_bit_cast(bf16x8, hi ? z : e1); }
  bool fold = false;
#define FOLD_PREP(j) do { fold = false; if constexpr (ALIBI && DQK == 64) { const int cls_ = __builtin_amdgcn_readfirstlane(tcls[j]); fold = (cls_ != 0); \
    if (fold) { const float P0 = tp0[j]; const float c = ((cls_ == 1) ? -sp : sp) * (pq - P0); \
      const unsigned c1b = cvt_pk_bf16(c, 0.f) & 0xffffu; const float q1 = c - __uint_as_float(c1b << 16); const unsigned c2b = cvt_pk_bf16(q1, 0.f) & 0xffffu; const float q2 = q1 - __uint_as_float(c2b << 16); \
      const unsigned c3b = cvt_pk_bf16(q2, 0.f) & 0xffffu; const unsigned sg = (cls_ == 1) ? 0u : 0x80008000u; \
      const u32x4 w = {w0pos ^ sg, (s3b ^ (sg & 0x8000u)) | (c1b << 16), c2b | (c3b << 16), 0u}, z = {0u, 0u, 0u, 0u}; qext = __builtin_bit_cast(bf16x8, hi ? z : w); } } } while (0)
#define QK_LOAD(KS) do { } while (0)
#define POS_LOAD(KS) do { if (ALIBI && !fold) { _Pragma("unroll") for (int g = 0; g < 4; ++g) { pkv[g] = *(const LAS f32x4*)(pos_l + (KS) * 64 + 8 * g + 4 * hi); pkv[4 + g] = *(const LAS f32x4*)(pos_l + (KS) * 64 + 32 + 8 * g + 4 * hi); } SBAR(); } } while (0)
#define QK_MMA(X0, X1, KS) do { qkt_d<DQK>(X0, X1, Kn0 + (KS) * 16384, Kr0 + (KS) * 8192, qr, qx, negm, r32, hi); \
    if constexpr (DQK == 64) { if (fold) { X0 = __builtin_amdgcn_mfma_f32_32x32x16_bf16(kext0, qext, X0, 0, 0, 0); X1 = __builtin_amdgcn_mfma_f32_32x32x16_bf16(kext1, qext, X1, 0, 0, 0); } } } while (0)
  QK_LOAD(0); POS_LOAD(0); QK_MMA(pA0, pA1, 0);
  if constexpr (FIXREF) { alA = 1.f; alB = 1.f;
    if constexpr (ALIBI) {
#pragma unroll
      for (int g = 0; g < 4; ++g) { const f32x4 a = pkv[g], b = pkv[4 + g];
#pragma unroll
        for (int j = 0; j < 4; ++j) { pA0[4 * g + j] = fmaf(fabsf(a[j] - pq), nsl, pA0[4 * g + j]); pA1[4 * g + j] = fmaf(fabsf(b[j] - pq), nsl, pA1[4 * g + j]); } } }
#pragma unroll
    for (int r = 0; r < 16; ++r) pA0[r] = __builtin_amdgcn_exp2f(pA0[r]); }
  else softmax_a<ALIBI, true>(pA0, pA1, mhat, negm, l_reg, alA, pkv, pq, nsl);
  WAITBAR();
  if (2 < NT) DMA_K(2, 0);
  DMA_V(1, 1);
#define HALF(j, X0, X1, alX, Y0, Y1, KS, VS) do { SBAR(); \
    FOLD_PREP(j); QK_LOAD(KS); sm_exp1(Y1); SBAR(); \
    QK_MMA(X0, X1, KS); sm_sumpack(Y0, Y1, l_reg, pa0, pa1, pa2, pa3); SBAR(); \
    { float mx_ = -3.0e38f; const int vb_ = vb0 + (VS) * 16384; \
      pv_sm_one<ALIBI, 0, FIXREF>(o[0], vb_, pa0, pa1, pa2, pa3, X0, X1, mx_, pos_l + (KS) * 64, hi, pq, nsl, fold); pv_sm_one<ALIBI, 1, FIXREF>(o[1], vb_, pa0, pa1, pa2, pa3, X0, X1, mx_, pos_l + (KS) * 64, hi, pq, nsl, fold); \
      pv_sm_one<ALIBI, 2, FIXREF>(o[2], vb_, pa0, pa1, pa2, pa3, X0, X1, mx_, pos_l + (KS) * 64, hi, pq, nsl, fold); pv_sm_one<ALIBI, 3, FIXREF>(o[3], vb_, pa0, pa1, pa2, pa3, X0, X1, mx_, pos_l + (KS) * 64, hi, pq, nsl, fold); \
      if constexpr (FIXREF) { _Pragma("unroll") for (int r_ = 0; r_ < 16; ++r_) X0[r_] = __builtin_amdgcn_exp2f(X0[r_]); } else sm_tail<false>(X0, X1, mx_, mhat, negm, l_reg, alX); } \
    WAITBAR(); \
    if ((j) + 2 < NT) DMA_K((j) + 2, KS); \
    if ((j) + 1 < NT) DMA_V((j) + 1, (VS)); \
    if constexpr (!FIXREF) RESC(alX); } while (0)
  for (int j = 1; j + 1 < NT; j += 2) {
    HALF(j, pB0, pB1, alB, pA0, pA1, 1, 0);
    HALF(j + 1, pA0, pA1, alA, pB0, pB1, 0, 1);
  }
  HALF(NT - 1, pB0, pB1, alB, pA0, pA1, 1, 0);
  softmax_b(pB0, pB1, l_reg, pa0, pa1, pa2, pa3); SBAR();
  pv_d0(o, vb0 + 16384, pa0, pa1, pa2, pa3);
  { const int te = fresh_tid(wave_s); const int wid_e = te >> 6, r32e = te & 31, hie = (te >> 5) & 1;
    LAS float* li_e = (LAS float*)(lds + D_OFF_WS) + wid_e * 64;
    if (hie == 0) li_e[r32e] = l_reg; asm volatile("s_waitcnt lgkmcnt(0)" ::: "memory");
    float rli[16];
#pragma unroll
    for (int r = 0; r < 16; ++r) rli[r] = __builtin_amdgcn_rcpf(li_e[crow(r, hie)]);
    bf16* Ow = Ob + (long)(wid_e * QBLK) * ldo;
    if constexpr (EPI == 1) {
#pragma unroll
      for (int r = 0; r < 16; ++r) { const unsigned w0 = cvt_pk_bf16(o[0][r] * rli[r], o[1][r] * rli[r]), w1 = cvt_pk_bf16(o[2][r] * rli[r], o[3][r] * rli[r]);
        LAS unsigned* sp = (LAS unsigned*)(lds + (r < 8 ? D_OFF_KN : D_OFF_QX) + ((2 * r) & 15) * 2048 + te * 4); sp[0] = w0; sp[512] = w1; }
    } else if constexpr (EPI == 2) {
      float gv[4];
#pragma unroll
      for (int d0 = 0; d0 < 4; ++d0) gv[d0] = gsub[d0 * 32 + r32e] * omli;
#pragma unroll
      for (int r = 0; r < 16; ++r) { const int orow = crow(r, hie);
        const LAS unsigned* sp = (const LAS unsigned*)(lds + (r < 8 ? D_OFF_KN : D_OFF_QX) + ((2 * r) & 15) * 2048 + te * 4); const unsigned w0 = sp[0], w1 = sp[512];
        float d[4] = {bf_lo(w0), bf_hi(w0), bf_lo(w1), bf_hi(w1)};
        const unsigned v0 = cvt_pk_bf16(o[0][r] * rli[r], o[1][r] * rli[r]), v1 = cvt_pk_bf16(o[2][r] * rli[r], o[3][r] * rli[r]);
        d[0] -= lam * bf_lo(v0); d[1] -= lam * bf_hi(v0); d[2] -= lam * bf_lo(v1); d[3] -= lam * bf_hi(v1);
        float s = (d[0] * d[0] + d[1] * d[1]) + (d[2] * d[2] + d[3] * d[3]);
        s += xshfl<1>(s); s += xshfl<2>(s); s += xshfl<4>(s); s += xshfl<8>(s); s += xshfl<16>(s);
        const float rstd = 1.0f / sqrtf(s * (1.f / 128) + EPS);
#pragma unroll
        for (int d0 = 0; d0 < 4; ++d0) Ow[(long)orow * ldo + d0 * 32 + r32e] = (bf16)(cvt_pk_bf16(d[d0] * rstd * gv[d0], 0.f) & 0xffffu); }
    } else {
#pragma unroll
    for (int r = 0; r < 16; ++r) { const int orow = crow(r, hie);
#pragma unroll
      for (int d0 = 0; d0 < 4; ++d0) Ow[(long)orow * ldo + d0 * 32 + r32e] = (bf16)(cvt_pk_bf16(o[d0][r] * rli[r], 0.f) & 0xffffu); } } }
  asm volatile("s_waitcnt lgkmcnt(0)\n\ts_barrier" ::: "memory");
#undef DMA_K
#undef DMA_V
#undef WAITBAR
#undef RESC
#undef HALF
#undef QK_LOAD
#undef FOLD_PREP
#undef POS_LOAD
#undef QK_MMA
}

typedef int i32x8 __attribute__((ext_vector_type(8)));
constexpr int SC_Q16 = 0x7B7B7B7B;
__device__ __forceinline__ void qkt_f8(f32x16& p0, f32x16& p1, const lptr Kn, const lptr Kr, const i32x8 (&qf)[3], const f32x16& negm, int r32, int hi) {
  const lptr rn = Kn + r32 * 128, rr = Kr + r32 * 64; const int k8 = (r32 >> 1) & 7, k4 = (r32 >> 2) & 3;
#pragma unroll
  for (int s = 0; s < 3; ++s) {
    u32x4 a, b, c, d;
    if (s < 2) { const int c0 = ((4 * s + 2 * hi) ^ k8) << 4, c1 = ((4 * s + 2 * hi + 1) ^ k8) << 4;
      a = *(const LAS u32x4*)(rn + c0); b = *(const LAS u32x4*)(rn + c1); c = *(const LAS u32x4*)(rn + 4096 + c0); d = *(const LAS u32x4*)(rn + 4096 + c1); }
    else { const int c0 = ((2 * hi) ^ k4) << 4, c1 = ((2 * hi + 1) ^ k4) << 4;
      a = *(const LAS u32x4*)(rr + c0); b = *(const LAS u32x4*)(rr + c1); c = *(const LAS u32x4*)(rr + 2048 + c0); d = *(const LAS u32x4*)(rr + 2048 + c1); }
    const i32x8 A0 = {(int)a.x, (int)a.y, (int)a.z, (int)a.w, (int)b.x, (int)b.y, (int)b.z, (int)b.w}, A1 = {(int)c.x, (int)c.y, (int)c.z, (int)c.w, (int)d.x, (int)d.y, (int)d.z, (int)d.w};
    if (s == 0) { p0 = __builtin_amdgcn_mfma_scale_f32_32x32x64_f8f6f4(A0, qf[0], negm, 0, 0, 0, 0, 0, 0); p1 = __builtin_amdgcn_mfma_scale_f32_32x32x64_f8f6f4(A1, qf[0], negm, 0, 0, 0, 0, 0, 0); }
    else { p0 = __builtin_amdgcn_mfma_scale_f32_32x32x64_f8f6f4(A0, qf[s], p0, 0, 0, 0, 0, 0, 0); p1 = __builtin_amdgcn_mfma_scale_f32_32x32x64_f8f6f4(A1, qf[s], p1, 0, 0, 0, 0, 0, 0); } }
}
__device__ __forceinline__ void attn_unit_mla8(const bf16* __restrict__ Qb, int ldq, const unsigned char* __restrict__ K8h, int ldk8, const unsigned char* __restrict__ KR8, const unsigned char* __restrict__ VT8h,
                                               bf16* __restrict__ Ob, int ldo, const int seq, const lptr lds, const int wave_s, const float* __restrict__ gq1, const float* __restrict__ gq2, const float* __restrict__ ropeq) {
  const int tid = fresh_tid(wave_s), lane = tid & 63, r32 = lane & 31, hi = lane >> 5; const int wid = __builtin_amdgcn_readfirstlane(tid >> 6);
  LAS float* wsf = (LAS float*)(lds + D_OFF_WS) + wid * 64; LAS float* al_l = wsf + 32;
  unsigned vo, kno, kro;
  { const int n = 16 * wid + (lane >> 2), g = (lane & 3) ^ ((n >> 2) & 3); vo = (unsigned)(n * 64 + g * 16); }
  { const int row = 8 * wid + (lane >> 3), c = (lane & 7) ^ ((row >> 1) & 7); kno = (unsigned)(row * ldk8 + c * 16); }
  { const int row = 16 * (wid & 3) + (lane >> 2), c = (lane & 3) ^ ((row >> 2) & 3); kro = (unsigned)(row * 64 + c * 16); }
  const lptr vdst = lds + D_OFF_V + wid * 1024, kndst = lds + D_OFF_KN + wid * 1024, krdst = lds + D_OFF_KR + (wid & 3) * 1024;
#define DMA_K(t, s) do { glds16s((const char*)K8h + (size_t)(t) * KVBLK * ldk8, kno, kndst + (s) * 8192); if (wid < 4) glds16s((const char*)KR8 + (size_t)(t) * (KVBLK * 64), kro, krdst + (s) * 4096); } while (0)
#define DMA_V(t, s) glds16s((const char*)VT8h + (size_t)(t) * 8192, vo, vdst + (s) * 8192)
#define WAITBAR() asm volatile("s_waitcnt vmcnt(0) lgkmcnt(0)\n\ts_barrier" ::: "memory")
#define RESC(a) do { if (__any((a) < 1.f)) { if (hi == 0) al_l[r32] = (a); asm volatile("s_waitcnt lgkmcnt(0)" ::: "memory"); \
    _Pragma("unroll") for (int r = 0; r < 16; ++r) { const float a_ = al_l[crow(r, hi)]; o[0][r] *= a_; o[1][r] *= a_; o[2][r] *= a_; o[3][r] *= a_; ol[r] *= a_; } } } while (0)
  const int NT = seq / KVBLK;
  DMA_K(0, 0); DMA_V(0, 0); DMA_K(1, 1); DMA_K(2, 2); DMA_K(3, 3); DMA_V(1, 1); DMA_V(2, 2);
  const i32x8 ones8 = {0x22222222, 0x22222222, 0x22222222, 0x22222222, 0, 0, 0, 0};
  float mhat = 0.f; f32x16 o[4] = {}; f32x16 ol = {}; i32x8 qf[3]; f32x16 negm = f32x16{}; asm volatile("" : "+v"(negm));
  { const bf16* Qw = Qb + (long)(wid * QBLK + r32) * ldq + hi * 32;
    constexpr float QS16 = MLA_SQS;
    u32x4 raw[3][4];
#pragma unroll
    for (int s = 0; s < 3; ++s)
#pragma unroll
      for (int i = 0; i < 4; ++i) raw[s][i] = *(const u32x4*)(Qw + 64 * s + 8 * i);
    float ssn = 0.f, ssr = 0.f;
#pragma unroll
    for (int s = 0; s < 2; ++s)
#pragma unroll
      for (int i = 0; i < 4; ++i) { float f[8]; unpack8(raw[s][i], f); ssn += ssq8(f); }
#pragma unroll
    for (int i = 0; i < 4; ++i) { float f[8]; unpack8(raw[2][i], f); ssr += ssq8(f); }
    { auto rr = __builtin_amdgcn_permlane32_swap(__float_as_uint(ssn), __float_as_uint(ssn), false, false); ssn = __uint_as_float(rr[0]) + __uint_as_float(rr[1]); }
    { auto rr = __builtin_amdgcn_permlane32_swap(__float_as_uint(ssr), __float_as_uint(ssr), false, false); ssr = __uint_as_float(rr[0]) + __uint_as_float(rr[1]); }
    const float rn = QS16 / sqrtf(ssn * (1.f / NOPE) + EPS), rr_ = 1.0f / sqrtf(ssr * (1.f / ROPE) + EPS);
#pragma unroll
    for (int s = 0; s < 2; ++s)
#pragma unroll
      for (int i = 0; i < 4; ++i) { float f[8]; unpack8(raw[s][i], f); const f32x4 g0 = *(const f32x4*)(gq1 + 64 * s + 32 * hi + 8 * i), g1 = *(const f32x4*)(gq1 + 64 * s + 32 * hi + 8 * i + 4);
#pragma unroll
        for (int e = 0; e < 4; ++e) { f[e] *= rn * g0[e]; f[4 + e] *= rn * g1[e]; }
        qf[s][2 * i] = (int)pk4_fp8(f[0], f[1], f[2], f[3]); qf[s][2 * i + 1] = (int)pk4_fp8(f[4], f[5], f[6], f[7]); }
    const float* rp = ropeq + (size_t)(wid * QBLK + r32) * 64;
#pragma unroll
    for (int i = 0; i < 4; ++i) { float f[8], o8[8]; unpack8(raw[2][i], f);
#pragma unroll
      for (int e = 0; e < 8; ++e) { const float x = f[e] * rr_ * gq2[32 * hi + 8 * i + e];
        auto sw = __builtin_amdgcn_permlane32_swap(__float_as_uint(x), __float_as_uint(x), false, false); const float a = __uint_as_float(sw[0]), b = __uint_as_float(sw[1]);
        const float c = rp[2 * (8 * i + e)], s = rp[2 * (8 * i + e) + 1]; o8[e] = (hi ? (b * c + a * s) : (a * c - b * s)) * QS16; }
      qf[2][2 * i] = (int)pk4_fp8(o8[0], o8[1], o8[2], o8[3]); qf[2][2 * i + 1] = (int)pk4_fp8(o8[4], o8[5], o8[6], o8[7]); } }
  const lptr Kn0 = lds + D_OFF_KN, Kr0 = lds + D_OFF_KR;
  const lptr Vr0 = lds + D_OFF_V + r32 * 64 + (((2 * hi) ^ ((r32 >> 2) & 3)) << 4), Vr1 = lds + D_OFF_V + r32 * 64 + (((2 * hi + 1) ^ ((r32 >> 2) & 3)) << 4);
  f32x16 pA0, pA1, pB0, pB1; float alA, alB; i32x8 pa8;
  WAITBAR();
#define QK_MMA(X0, X1, KS) qkt_f8(X0, X1, Kn0 + (KS) * 8192, Kr0 + (KS) * 4096, qf, negm, r32, hi)
#define I8(a, b) (i32x8){(int)a.x, (int)a.y, (int)a.z, (int)a.w, (int)b.x, (int)b.y, (int)b.z, (int)b.w}
#define PV8(D, VS) do { const u32x4 v0_ = *(const LAS u32x4*)(Vr0 + (VS) * 8192 + (D) * 2048), v1_ = *(const LAS u32x4*)(Vr1 + (VS) * 8192 + (D) * 2048); \
    o[D] = __builtin_amdgcn_mfma_scale_f32_32x32x64_f8f6f4(pa8, I8(v0_, v1_), o[D], 0, 0, 0, 0, 0, 0); } while (0)
#define CV8(a, b, c, d) (int)__builtin_amdgcn_cvt_pk_fp8_f32(c, d, __builtin_amdgcn_cvt_pk_fp8_f32(a, b, 0, false), true)
#define SUMPACK8(Y0, Y1) do { \
    _Pragma("unroll") for (int j_ = 0; j_ < 4; ++j_) { pa8[j_] = CV8(Y0[4 * j_], Y0[4 * j_ + 1], Y0[4 * j_ + 2], Y0[4 * j_ + 3]); pa8[4 + j_] = CV8(Y1[4 * j_], Y1[4 * j_ + 1], Y1[4 * j_ + 2], Y1[4 * j_ + 3]); } } while (0)
#define ROWMAX(X0, X1, rm) do { float a_ = MX3(X0[0], X0[1], X1[0]), b_ = MX3(X0[2], X0[3], X1[1]); a_ = MX3(a_, X1[2], X1[3]); \
    _Pragma("unroll") for (int r_ = 4; r_ < 16; r_ += 4) { a_ = MX3(a_, X0[r_], X0[r_ + 1]); b_ = MX3(b_, X0[r_ + 2], X0[r_ + 3]); a_ = MX3(a_, X1[r_], X1[r_ + 1]); b_ = MX3(b_, X1[r_ + 2], X1[r_ + 3]); } \
    rm = fmaxf(a_, b_); { auto rr_ = __builtin_amdgcn_permlane32_swap(__float_as_uint(rm), __float_as_uint(rm), false, false); rm = fmaxf(__uint_as_float(rr_[0]), __uint_as_float(rr_[1])); } } while (0)
#define REREF(X0, X1, dl_) do { mhat += dl_; \
    _Pragma("unroll") for (int r_ = 0; r_ < 16; ++r_) { X0[r_] -= dl_; X1[r_] -= dl_; } \
    _Pragma("unroll") for (int r_ = 0; r_ < 16; ++r_) negm[r_] = -mhat; \
    asm volatile("" : "+v"(negm)); } while (0)
#define EXP16(P) do { _Pragma("unroll") for (int r_ = 0; r_ < 16; ++r_) P[r_] = __builtin_amdgcn_exp2f(P[r_]); } while (0)
  QK_MMA(pA0, pA1, 0);
  { float rm; ROWMAX(pA0, pA1, rm); const float dl = rm - 4.0f; REREF(pA0, pA1, dl); alA = 1.f; EXP16(pA0); }
#define HALF(j, X0, X1, alX, Y0, Y1, KS, VS, BAR) do { SBAR(); \
    EXP16(Y1); SBAR(); \
    QK_MMA(X0, X1, KS); SUMPACK8(Y0, Y1); SBAR(); \
    PV8(0, VS); PV8(1, VS); \
    { float rm_; ROWMAX(X0, X1, rm_); alX = 1.f; \
      if (__builtin_expect(__any(rm_ > 8.0f), 0)) { const float dl_ = fmaxf(rm_ - 4.0f, 0.f); REREF(X0, X1, dl_); alX = __builtin_amdgcn_exp2f(-dl_); } } \
    PV8(2, VS); PV8(3, VS); ol = __builtin_amdgcn_mfma_scale_f32_32x32x64_f8f6f4(pa8, ones8, ol, 0, 4, 0, 0, 0, 0); \
    EXP16(X0); asm volatile("" : "+v"(X0)); SBAR(); \
    if (BAR) { WAITBAR();     \
      if ((j) + 3 < NT) DMA_K((j) + 3, ((KS) + 3) & 3); \
      if ((j) + 2 < NT) DMA_V((j) + 2, ((VS) + 3) & 3); } \
    else { if ((j) + 3 < NT) DMA_K((j) + 3, ((KS) + 3) & 3); if ((j) + 2 < NT) DMA_V((j) + 2, ((VS) + 3) & 3); }     \
    RESC(alX); } while (0)
  for (int j = 1; j + 3 < NT; j += 4) {
    HALF(j, pB0, pB1, alB, pA0, pA1, 1, 0, 1);
    HALF(j + 1, pA0, pA1, alA, pB0, pB1, 2, 1, 0);
    HALF(j + 2, pB0, pB1, alB, pA0, pA1, 3, 2, 1);
    HALF(j + 3, pA0, pA1, alA, pB0, pB1, 0, 3, 0);
  }
  HALF(NT - 3, pB0, pB1, alB, pA0, pA1, 1, 0, 1);
  HALF(NT - 2, pA0, pA1, alA, pB0, pB1, 2, 1, 0);
  HALF(NT - 1, pB0, pB1, alB, pA0, pA1, 3, 2, 1);
  EXP16(pB1); SUMPACK8(pB0, pB1); SBAR();
  PV8(0, 3); PV8(1, 3); PV8(2, 3); PV8(3, 3); ol = __builtin_amdgcn_mfma_scale_f32_32x32x64_f8f6f4(pa8, ones8, ol, 0, 4, 0, 0, 0, 0);
  { const int te = fresh_tid(wave_s); const int wid_e = te >> 6, r32e = te & 31, hie = (te >> 5) & 1;
    float rli[16];
#pragma unroll
    for (int r = 0; r < 16; ++r) rli[r] = 0.25f * __builtin_amdgcn_rcpf(ol[r]);
    bf16* Ow = Ob + (long)(wid_e * QBLK) * ldo;
#pragma unroll
    for (int r = 0; r < 16; ++r) { const int orow = crow(r, hie);
#pragma unroll
      for (int d0 = 0; d0 < 4; ++d0) { if (MLA_GA8) { const float v_ = clamp_fp8(o[d0][r] * rli[r] * 64.0f); ((unsigned char*)Ob)[(long)(wid_e * QBLK + orow) * ldo + d0 * 32 + r32e] = (unsigned char)(__builtin_amdgcn_cvt_pk_fp8_f32(v_, v_, 0, false) & 0xff); }
        else Ow[(long)orow * ldo + d0 * 32 + r32e] = (bf16)(cvt_pk_bf16(o[d0][r] * rli[r], 0.f) & 0xffffu); } } }
  asm volatile("s_waitcnt lgkmcnt(0)\n\ts_barrier" ::: "memory");
#undef DMA_K
#undef DMA_V
#undef WAITBAR
#undef RESC
#undef HALF
#undef QK_MMA
#undef I8
#undef PV8
#undef CV8
#undef SUMPACK8
#undef ROWMAX
#undef REREF
#undef EXP16
}
#undef SBAR
}

constexpr size_t MiB = 1u << 20;
constexpr size_t WS_CTL = 0, CTL_ZERO_BYTES = 1 * MiB;
constexpr size_t WS_ROPE = 1 * MiB;
constexpr size_t WS_POSF = 9 * MiB;
constexpr size_t WS_TMM = WS_POSF + 256 * 1024, WS_QMM = WS_TMM + 8 * 1024, WS_TFL = WS_QMM + 4 * 1024;
constexpr int D_OFF_TT_DUMMY = 0;
constexpr size_t WS_MOE = 10 * MiB;
constexpr size_t MOE_TOPI = WS_MOE, MOE_TOPW = MOE_TOPI + (size_t)T * 2 * 4, MOE_BCNT = MOE_TOPW + (size_t)T * 2 * 4, MOE_TOK = MOE_BCNT + 256 * 16 * 4,
                 MOE_WTL = MOE_TOK + (size_t)2 * NPMAX * 4, MOE_TEX = MOE_WTL + (size_t)2 * NPMAX * 4, MOE_NTR = MOE_TEX + 2 * 256 * 4, MOE_END = MOE_NTR + 64;
static_assert(MOE_END <= 12 * MiB, "routing tables");
constexpr size_t WS_SSQ = 11 * MiB + MiB / 4;
static_assert(MOE_END <= WS_SSQ && WS_SSQ + (size_t)T * 16 <= 12 * MiB, "ssq table");
constexpr size_t WS_W = 12 * MiB, W_LAYER = 20 * MiB + MiB / 2;
constexpr size_t W_1A = 0, W_1B = 2 * MiB, W_UQ = 12 * MiB, W_UKV = 13 * MiB + MiB / 2, W_A = 14 * MiB + MiB / 2, W_B = 16 * MiB + MiB / 2, W_O = 18 * MiB + MiB / 2;
constexpr size_t WS_WGU = 53 * MiB, WS_WD = 64 * MiB;
constexpr size_t WS_R = 70 * MiB;
constexpr size_t R_H = WS_R, R_CQKV = WS_R + 64 * MiB, R_Q = WS_R + 128 * MiB, R_KV = WS_R + 224 * MiB, R_KR = WS_R + 352 * MiB, R_VT8 = WS_R + 356 * MiB, R_OA = WS_R + 406 * MiB;
constexpr size_t R_DQKV = WS_R + 64 * MiB, R_O01 = WS_R + 256 * MiB, R_OB = WS_R + 320 * MiB, R_GATES = WS_R + 128 * MiB, R_PAG = WS_R + 256 * MiB, R_MRG = WS_R + 64 * MiB;
constexpr size_t R_ACTD = WS_R + 64 * MiB;
constexpr size_t R_WMOE = WS_R + 64 * MiB, R_ACTM = WS_R + 232 * MiB;
constexpr size_t WMOE_GU = 14 * MiB, WMOE_D = 7 * MiB;
constexpr size_t WS_END = R_ACTM + (size_t)NPMAX * FFE * 2;
static_assert(WS_END <= 542 * MiB, "d_ws map");
constexpr int CW_BAR = 4096;
constexpr int CW_QUEUE = 8192;

constexpr int LDS_BYTES = 147456;
constexpr int MISC_OFF = 143360;

#define XB_TMO      128
#define XB_XCNT(j)  (256  + 64 * (j))
#define XB_XSUB(j)  (1280 + 64 * (j))
#define XB_XGEN(j)  (2304 + 64 * (j))
#define XB_TOP      3328
#define XB_TOPGEN   3392
#define XCD_BAR_WORDS 3456
#define XB_SPIN_CAP (1u << 18)
__device__ __forceinline__ unsigned xb_ld(unsigned* p)              { return __hip_atomic_load(p, __ATOMIC_RELAXED, __HIP_MEMORY_SCOPE_AGENT); }
__device__ __forceinline__ unsigned xb_add(unsigned* p, unsigned v) { return __hip_atomic_fetch_add(p, v, __ATOMIC_RELAXED, __HIP_MEMORY_SCOPE_AGENT); }
__device__ __forceinline__ unsigned xb_xcc_id() { return (unsigned)__builtin_amdgcn_s_getreg((3 << 11) | 20) & 0xFu; }
#define XB_SPIN(cond, bar) do { unsigned _sp = 0; while (cond) { __builtin_amdgcn_s_sleep(1); \
    if ((++_sp & 255u) == 0u) { if (xb_ld(&(bar)[XB_TMO])) break; if (_sp > XB_SPIN_CAP) { atomicAdd(&(bar)[XB_TMO], 1u); break; } } } } while (0)
struct XcdBarrier { unsigned* bar; unsigned x; volatile LAS unsigned* st; };
__device__ __forceinline__ XcdBarrier xcd_barrier_post(unsigned* bar, volatile LAS unsigned* st) {
    XcdBarrier b; b.bar = bar; b.x = xb_xcc_id(); b.st = st;
    if (threadIdx.x == 0) (void)xb_add(&bar[XB_XCNT(b.x)], 1u);
    return b;
}
__device__ __forceinline__ void xcd_barrier_complete(unsigned* bar, unsigned x, unsigned& nloc, unsigned& nx) {
    const unsigned G = gridDim.x * gridDim.y * gridDim.z;
    unsigned sum, cnt, mine, sp = 0u;
    for (;;) {
        sum = 0u; cnt = 0u; mine = 0u;
#pragma unroll
        for (unsigned j = 0; j < 16; ++j) { const unsigned c = xb_ld(&bar[XB_XCNT(j)]); sum += c; cnt += (c > 0u) ? 1u : 0u; mine = (j == x) ? c : mine; }
        if (sum == G) break;
        __builtin_amdgcn_s_sleep(1);
        if ((++sp & 255u) == 0u) { if (xb_ld(&bar[XB_TMO])) break; if (sp > XB_SPIN_CAP) { atomicAdd(&bar[XB_TMO], 1u); break; } }
    }
    nloc = mine > 0u ? mine : 1u; nx = cnt > 0u ? cnt : 1u;
}
__device__ __forceinline__ void xcd_barrier(const XcdBarrier& b, const bool leader) {
    asm volatile("s_waitcnt vmcnt(0)" ::: "memory");
    __syncthreads();
    if (leader) {
        unsigned* bar = b.bar; asm volatile("" : "+s"(bar));
        __builtin_amdgcn_s_waitcnt(0);
        unsigned bx_ = __builtin_amdgcn_readfirstlane(b.x); asm volatile("" : "+s"(bx_));
        unsigned nloc = b.st[0], nx = b.st[1];
        if (nloc == 0u) { xcd_barrier_complete(bar, bx_, nloc, nx); b.st[0] = nloc; b.st[1] = nx; }
        const unsigned old = xb_add(&bar[XB_XSUB(bx_)], 1u);
        const unsigned gen = old / nloc;
        if (old + 1u == (gen + 1u) * nloc) {
            __builtin_amdgcn_fence(__ATOMIC_RELEASE, "agent");
            asm volatile("s_waitcnt vmcnt(0)" ::: "memory");
            const unsigned og = xb_add(&bar[XB_TOP], 1u);
            const unsigned tg = og / nx;
            if (og + 1u == (tg + 1u) * nx) xb_add(&bar[XB_TOPGEN], 1u);
            else XB_SPIN(xb_ld(&bar[XB_TOPGEN]) == tg, bar);
            __builtin_amdgcn_fence(__ATOMIC_ACQUIRE, "agent");
            xb_add(&bar[XB_XGEN(bx_)], 1u);
            asm volatile("s_waitcnt vmcnt(0)" ::: "memory");
        } else {
            XB_SPIN(xb_ld(&bar[XB_XGEN(bx_)]) == gen, bar);
            __builtin_amdgcn_fence(__ATOMIC_ACQUIRE, "agent");
            asm volatile("s_waitcnt vmcnt(0)" ::: "memory");
        }
    }
    __syncthreads();
}

__device__ const double INV_FREQ[32] = {1, 0.74989420933245587, 0.56234132519034907, 0.42169650342858223, 0.31622776601683794, 0.23713737056616552, 0.17782794100389229, 0.1333521432163324,
    0.10000000000000001, 0.074989420933245579, 0.056234132519034911, 0.042169650342858224, 0.031622776601683791, 0.023713737056616554, 0.017782794100389229, 0.013335214321633241,
    0.01, 0.0074989420933245579, 0.005623413251903491, 0.0042169650342858229, 0.0031622776601683794, 0.0023713737056616554, 0.0017782794100389228, 0.0013335214321633241,
    0.001, 0.00074989420933245586, 0.0005623413251903491, 0.00042169650342858224, 0.00031622776601683794, 0.00023713737056616554, 0.00017782794100389227, 0.0001333521432163324};

__device__ __forceinline__ void tr_tile(const float* __restrict__ W, int N, int k0, int n0, bf16* __restrict__ dst, int ldd, int drow0, const float* __restrict__ ks, LAS float* scr, int lane) {
#pragma unroll
    for (int h = 0; h < 2; ++h) { float v[32];
#pragma unroll
        for (int i = 0; i < 32; ++i) v[i] = W[(size_t)(k0 + 32 * h + i) * N + n0 + lane];
        if (ks) {
#pragma unroll
            for (int i = 0; i < 32; ++i) v[i] *= ks[k0 + 32 * h + i]; }
#pragma unroll
        for (int i = 0; i < 32; ++i) scr[(32 * h + i) * 65 + lane] = v[i]; }
    asm volatile("s_waitcnt lgkmcnt(0)" ::: "memory");
    const int c = lane & 7;
#pragma unroll
    for (int j = 0; j < 8; ++j) { const int n = (lane >> 3) + 8 * j; const LAS float* s = scr + (8 * c) * 65 + n;
        u32x4 o; o.x = cvt_pk_bf16(s[0 * 65], s[1 * 65]); o.y = cvt_pk_bf16(s[2 * 65], s[3 * 65]); o.z = cvt_pk_bf16(s[4 * 65], s[5 * 65]); o.w = cvt_pk_bf16(s[6 * 65], s[7 * 65]);
        *(u32x4*)(dst + (size_t)(drow0 + n) * ldd + k0 + 8 * c) = o; }
    asm volatile("s_waitcnt lgkmcnt(0)" ::: "memory");
}
__device__ __forceinline__ void tr_item(const float* W, int K, int N, bf16* dst, bf16* dst2, int ldd, int mode, int roff, const float* ks, int item, LAS float* scr, int lane) {
    const int nblk = N / 64, kb = item / nblk, nb = item % nblk, k0 = kb * 64, n0 = nb * 64;
    bf16* d = dst; int drow0 = n0 + roff;
    if (mode == 1) { if (n0 >= 832) { d = dst2; drow0 = n0 - 832; } else if (MLA_G1F8) return; }
    else if (mode == 2) drow0 = 256 * (n0 >> 7) + (n0 & 127);
    else if (mode == 3) drow0 = 256 * (n0 >> 7) + 128 + (n0 & 127);
    tr_tile(W, N, k0, n0, d, ldd, drow0, ks, scr, lane);
}
__device__ __forceinline__ void tr_block(const float* __restrict__ W, int N, int k0, int n0, bf16* __restrict__ dst, int ldd, int mode, int roff, LAS float* scr, int tid) {
    const int wave = tid >> 6, lane = tid & 63;
    f32x4 v[8];
#pragma unroll
    for (int r = 0; r < 8; ++r) v[r] = *(const f32x4*)(W + (size_t)(k0 + wave * 8 + r) * N + n0 + 4 * lane);
#pragma unroll
    for (int r = 0; r < 8; ++r) { LAS float* s = scr + (wave * 8 + r) * 257 + 4 * lane; s[0] = v[r].x; s[1] = v[r].y; s[2] = v[r].z; s[3] = v[r].w; }
    __syncthreads();
    const int c = tid & 7, nb = tid >> 3;
#pragma unroll
    for (int j = 0; j < 4; ++j) { const int n = nb + 64 * j, na = n0 + n; const LAS float* s = scr + (8 * c) * 257 + n;
        const int drow = (mode == 2) ? 256 * (na >> 7) + (na & 127) : (mode == 3) ? 256 * (na >> 7) + 128 + (na & 127) : na + roff;
        u32x4 o; o.x = cvt_pk_bf16(s[0 * 257], s[1 * 257]); o.y = cvt_pk_bf16(s[2 * 257], s[3 * 257]); o.z = cvt_pk_bf16(s[4 * 257], s[5 * 257]); o.w = cvt_pk_bf16(s[6 * 257], s[7 * 257]);
        *(u32x4*)(dst + (size_t)drow * ldd + k0 + 8 * c) = o; }
    __syncthreads();
}
__device__ __forceinline__ void tr_block8(const float* __restrict__ W, int N, int k0, int n0, unsigned char* __restrict__ dst, int ldd, int mode, int roff, LAS float* scr, int tid) {
    const int wave = tid >> 6, lane = tid & 63;
    f32x4 v[8];
#pragma unroll
    for (int r = 0; r < 8; ++r) v[r] = *(const f32x4*)(W + (size_t)(k0 + wave * 8 + r) * N + n0 + 4 * lane);
#pragma unroll
    for (int r = 0; r < 8; ++r) { LAS float* s = scr + (wave * 8 + r) * 257 + 4 * lane; s[0] = v[r].x; s[1] = v[r].y; s[2] = v[r].z; s[3] = v[r].w; }
    __syncthreads();
    const int c = tid & 3, nb = tid >> 2;
#pragma unroll
    for (int j = 0; j < 2; ++j) { const int n = nb + 128 * j, na = n0 + n; const LAS float* s = scr + (16 * c) * 257 + n;
        const int drow = (mode == 2) ? 256 * (na >> 7) + (na & 127) : (mode == 3) ? 256 * (na >> 7) + 128 + (na & 127) : na + roff;
        u32x4 o; o.x = pk4_fp8(32.f * s[0 * 257], 32.f * s[1 * 257], 32.f * s[2 * 257], 32.f * s[3 * 257]); o.y = pk4_fp8(32.f * s[4 * 257], 32.f * s[5 * 257], 32.f * s[6 * 257], 32.f * s[7 * 257]);
        o.z = pk4_fp8(32.f * s[8 * 257], 32.f * s[9 * 257], 32.f * s[10 * 257], 32.f * s[11 * 257]); o.w = pk4_fp8(32.f * s[12 * 257], 32.f * s[13 * 257], 32.f * s[14 * 257], 32.f * s[15 * 257]);
        *(u32x4*)(dst + (size_t)drow * ldd + k0 + 16 * c) = o; }
    __syncthreads();
}
__device__ __forceinline__ void tr_block8x(const float* __restrict__ W, int N, int k0, int n0, unsigned char* __restrict__ dst, int ldd, int nmax, const float* __restrict__ ks, LAS float* scr, int tid) {
    const int wave = tid >> 6, lane = tid & 63;
    f32x4 v[8];
#pragma unroll
    for (int r = 0; r < 8; ++r) v[r] = *(const f32x4*)(W + (size_t)(k0 + wave * 8 + r) * N + n0 + 4 * lane);
#pragma unroll
    for (int r = 0; r < 8; ++r) { const float sc = ks ? 32.f * ks[k0 + wave * 8 + r] : 32.f; LAS float* s = scr + (wave * 8 + r) * 257 + 4 * lane; s[0] = sc * v[r].x; s[1] = sc * v[r].y; s[2] = sc * v[r].z; s[3] = sc * v[r].w; }
    __syncthreads();
    const int c = tid & 3, nb = tid >> 2;
#pragma unroll
    for (int j = 0; j < 2; ++j) { const int n = nb + 128 * j, na = n0 + n; const LAS float* s = scr + (16 * c) * 257 + n;
        u32x4 o; o.x = pk4_fp8(s[0 * 257], s[1 * 257], s[2 * 257], s[3 * 257]); o.y = pk4_fp8(s[4 * 257], s[5 * 257], s[6 * 257], s[7 * 257]);
        o.z = pk4_fp8(s[8 * 257], s[9 * 257], s[10 * 257], s[11 * 257]); o.w = pk4_fp8(s[12 * 257], s[13 * 257], s[14 * 257], s[15 * 257]);
        if (na < nmax) *(u32x4*)(dst + (size_t)na * ldd + k0 + 16 * c) = o; }
    __syncthreads();
}
__device__ __forceinline__ void tr_bitem8(const float* W, int K, int N, unsigned char* dst, int ldd, int mode, int roff, int item, LAS float* scr, int tid) {
    const int nblk = N / 256, kb = item / nblk, nb = item % nblk; tr_block8(W, N, kb * 64, nb * 256, dst, ldd, mode, roff, scr, tid);
}
__device__ __forceinline__ void tr_bitem(const float* W, int K, int N, bf16* dst, int ldd, int mode, int roff, int item, LAS float* scr, int tid) {
    const int nblk = N / 256, kb = item / nblk, nb = item % nblk; tr_block(W, N, kb * 64, nb * 256, dst, ldd, mode, roff, scr, tid);
}
__device__ __forceinline__ void norm_load(const float* __restrict__ xrow, int lane, f32x4 (&v)[4]) {
    const f32x4* xr = (const f32x4*)xrow + lane;
#pragma unroll
    for (int j = 0; j < 4; ++j) v[j] = xr[64 * j];
}
__device__ __forceinline__ void norm_fin(const float* __restrict__ g, bf16* __restrict__ orow, int lane, f32x4 (&v)[4]) {
    float s = 0.f;
#pragma unroll
    for (int j = 0; j < 4; ++j) s += (v[j].x * v[j].x + v[j].y * v[j].y) + (v[j].z * v[j].z + v[j].w * v[j].w);
    const float rstd = 1.0f / sqrtf(wave_sum(s) * (1.f / DM) + EPS);
    const f32x4* gr = (const f32x4*)g + lane; u32x2* o8 = (u32x2*)orow + lane;
#pragma unroll
    for (int j = 0; j < 4; ++j) { v[j] = v[j] * rstd * gr[64 * j]; u32x2 w; w.x = cvt_pk_bf16(v[j].x, v[j].y); w.y = cvt_pk_bf16(v[j].z, v[j].w); o8[64 * j] = w; }
}
__device__ __forceinline__ void norm_row(const float* __restrict__ xrow, const float* __restrict__ g, bf16* __restrict__ orow, int lane, f32x4 (&v)[4]) { norm_load(xrow, lane, v); norm_fin(g, orow, lane, v); }
__device__ __forceinline__ void norm_fin8(const float* __restrict__ g, unsigned char* __restrict__ orow, int lane, f32x4 (&v)[4]) {
    float s = 0.f;
#pragma unroll
    for (int j = 0; j < 4; ++j) s += (v[j].x * v[j].x + v[j].y * v[j].y) + (v[j].z * v[j].z + v[j].w * v[j].w);
    const float rstd = 1.0f / sqrtf(wave_sum(s) * (1.f / DM) + EPS);
    const f32x4* gr = (const f32x4*)g + lane; unsigned* o4 = (unsigned*)orow + lane;
#pragma unroll
    for (int j = 0; j < 4; ++j) { v[j] = v[j] * rstd * gr[64 * j]; o4[64 * j] = pk4_fp8(v[j].x, v[j].y, v[j].z, v[j].w); }
}
__device__ __forceinline__ void rope8(float (&y)[8], int sub, const float* __restrict__ rope) {
#pragma unroll
    for (int e = 0; e < 8; ++e) { const float yp = xshfl<4>(y[e]); const int i = (sub & 3) * 8 + e; const float c = rope[2 * i], s = rope[2 * i + 1];
        y[e] = (sub < 4) ? (y[e] * c - yp * s) : (y[e] * c + yp * s); }
}
template <int R>
__device__ __forceinline__ void e1_rows(bf16* __restrict__ C, bf16* __restrict__ KRp, const int (&t)[R], const float* __restrict__ g_kr, const float* __restrict__ ropeT, int lane) {
    u32x4 ra[R], rb[R];
#pragma unroll
    for (int i = 0; i < R; ++i) { const bf16* row = C + (size_t)t[i] * 1024; ra[i] = *(const u32x4*)(row + 8 * lane); rb[i] = *(const u32x4*)(row + 512 + 8 * lane); }
#pragma unroll
    for (int i = 0; i < R; ++i) { bf16* row = C + (size_t)t[i] * 1024;
        float fa[8], fb[8]; unpack8(ra[i], fa); unpack8(rb[i], fb);
        const float sa = ssq8(fa), sb = ssq8(fb);
        const float rq = 1.0f / sqrtf(wave_sum(sa) * (1.f / CQ) + EPS);
        const float rkv = 1.0f / sqrtf(wave_sum(lane < 32 ? sb : 0.f) * (1.f / CKV) + EPS);
        const bool iskr = (lane >= 32 && lane < 40);
        const float rkr = 1.0f / sqrtf(wave_sum(iskr ? sb : 0.f) * (1.f / ROPE) + EPS);
        float y[8]; const int sub = lane & 7;
#pragma unroll
        for (int e = 0; e < 8; ++e) { fa[e] *= rq; y[e] = fb[e] * rkr * g_kr[sub * 8 + e]; fb[e] *= rkv; }
        rope8(y, sub, ropeT + (size_t)t[i] * 64);
        *(u32x4*)(row + 8 * lane) = pack8(fa);
        if (lane < 32) *(u32x4*)(row + 512 + 8 * lane) = pack8(fb);
        if (iskr) *(u32x4*)(KRp + (size_t)t[i] * 64 + sub * 8) = pack8(y); }
}
template <int R>
__device__ __forceinline__ void kr_rows(const bf16* __restrict__ C, bf16* __restrict__ KRp, const int (&t)[R], const float* __restrict__ g_kr, const float* __restrict__ ropeT, int lane) {
    u32x4 rb[R];
#pragma unroll
    for (int i = 0; i < R; ++i) rb[i] = *(const u32x4*)(C + (size_t)t[i] * 1024 + 768 + 8 * (lane & 7));
#pragma unroll
    for (int i = 0; i < R; ++i) { float y[8]; unpack8(rb[i], y); const int sub = lane & 7;
        float s = ssq8(y); s += xshfl<1>(s); s += xshfl<2>(s); s += xshfl<4>(s);
        const float rstd = 1.0f / sqrtf(s * (1.f / ROPE) + EPS);
#pragma unroll
        for (int e = 0; e < 8; ++e) y[e] *= rstd * g_kr[sub * 8 + e];
        rope8(y, sub, ropeT + (size_t)t[i] * 64);
        if (MLA_FP8) { if (lane < 8) { u32x2 w; w.x = pk4_fp8(MLA_SQS * y[0], MLA_SQS * y[1], MLA_SQS * y[2], MLA_SQS * y[3]); w.y = pk4_fp8(MLA_SQS * y[4], MLA_SQS * y[5], MLA_SQS * y[6], MLA_SQS * y[7]); *(u32x2*)((unsigned char*)KRp + (size_t)t[i] * 64 + sub * 8) = w; } }
        else if (lane < 8) *(u32x4*)(KRp + (size_t)t[i] * 64 + sub * 8) = pack8(y); }
}
struct G16 { u32x4 a, b; };
__device__ __forceinline__ G16 g16_load(const bf16* __restrict__ p) { G16 r; r.a = *(const u32x4*)p; r.b = *(const u32x4*)(p + 8); return r; }
template <int NL> __device__ __forceinline__ void g16_fin(bf16* __restrict__ p, const G16 r, const float* __restrict__ g, int sub, const float post) {
    float a[8], b[8]; unpack8(r.a, a); unpack8(r.b, b);
    float s = ssq8(a) + ssq8(b);
    s += xshfl<1>(s); s += xshfl<2>(s); if (NL == 8) s += xshfl<4>(s);
    const float rstd = post / sqrtf(s * (1.f / (16 * NL)) + EPS);
#pragma unroll
    for (int e = 0; e < 8; ++e) { a[e] *= rstd * g[sub * 16 + e]; b[e] *= rstd * g[sub * 16 + 8 + e]; }
    *(u32x4*)p = pack8(a); *(u32x4*)(p + 8) = pack8(b);
}
template <int R>
__device__ __forceinline__ void e2_rows(bf16* __restrict__ KVp, const int (&t)[R], const float* g_kn, int lane) {
    const int h = lane >> 3, sub = lane & 7;
    G16 kn[R];
#pragma unroll
    for (int i = 0; i < R; ++i) kn[i] = g16_load(KVp + (size_t)t[i] * (MLA_H * 256) + h * 256 + sub * 16);
#pragma unroll
    for (int i = 0; i < R; ++i) g16_fin<8>(KVp + (size_t)t[i] * (MLA_H * 256) + h * 256 + sub * 16, kn[i], g_kn, sub, 1.0f);
}
template <int R>
__device__ __forceinline__ void e3_rows(bf16* __restrict__ D, const int (&t)[R], const float* g_k, int lane) {
    const int grp = lane >> 2, sub = lane & 3;
    G16 k[R];
#pragma unroll
    for (int i = 0; i < R; ++i) k[i] = g16_load(D + (size_t)t[i] * (3 * DM) + 1024 + grp * 64 + sub * 16);
#pragma unroll
    for (int i = 0; i < R; ++i) g16_fin<4>(D + (size_t)t[i] * (3 * DM) + 1024 + grp * 64 + sub * 16, k[i], g_k, sub, 1.0f);
}
template <int R>
__device__ __forceinline__ void e4_rows(const bf16* __restrict__ O, bf16* __restrict__ OBp, const int (&t)[R], const float* g, float lam, float omli, int lane) {
    const int h = lane >> 3, sub = lane & 7;
    G16 r0[R], r1[R];
#pragma unroll
    for (int i = 0; i < R; ++i) { const bf16* p0 = O + (size_t)t[i] * (2 * DM) + (h * 2) * 128 + sub * 16; r0[i] = g16_load(p0); r1[i] = g16_load(p0 + 128); }
#pragma unroll
    for (int i = 0; i < R; ++i) {
        float a0[8], b0[8], a1[8], b1[8]; unpack8(r0[i].a, a0); unpack8(r0[i].b, b0); unpack8(r1[i].a, a1); unpack8(r1[i].b, b1);
#pragma unroll
        for (int e = 0; e < 8; ++e) { a0[e] -= lam * a1[e]; b0[e] -= lam * b1[e]; }
        float s = ssq8(a0) + ssq8(b0); s += xshfl<1>(s); s += xshfl<2>(s); s += xshfl<4>(s);
        const float rstd = omli / sqrtf(s * (1.f / 128) + EPS);
#pragma unroll
        for (int e = 0; e < 8; ++e) { a0[e] *= rstd * g[sub * 16 + e]; b0[e] *= rstd * g[sub * 16 + 8 + e]; }
        bf16* o = OBp + (size_t)t[i] * DM + h * 128 + sub * 16; *(u32x4*)o = pack8(a0); *(u32x4*)(o + 8) = pack8(b0); }
}
#ifndef MK_MULTI
#define MK_MULTI 0
#endif
constexpr int NPH_LAYER = 20, NPHASES = 1 + NLAYER * NPH_LAYER;
struct Args { const void* in[31]; float* out; unsigned char* ws; int ph_lo, ph_hi; };
__global__ void __launch_bounds__(512, 2) fwd_kernel(Args args) {
    extern __shared__ __attribute__((aligned(16))) unsigned char lds_raw[];
    LAS unsigned char* lds = (LAS unsigned char*)lds_raw;
    volatile LAS unsigned* MISC = (volatile LAS unsigned*)(lds + MISC_OFF);
    const int G = gridDim.x, bx = blockIdx.x, vcu = (G % 8 == 0) ? (bx % 8) * (G / 8) + bx / 8 : bx;
    const int NGW = G * 8;
    const int wave_s = __builtin_amdgcn_readfirstlane((int)threadIdx.x >> 6);
#define MY_TID() fresh_tid(wave_s)
    for (int u = threadIdx.x; u < 32; u += 512) MISC[u] = 0u;
    __syncthreads();
    XcdBarrier bar = xcd_barrier_post((unsigned*)(args.ws + WS_CTL) + CW_BAR, MISC + 8);
#define PHASE_LOCALS int tid_l = MY_TID(); asm volatile("" : "+v"(tid_l)); const int tid = tid_l, lane = tid & 63, wave = __builtin_amdgcn_readfirstlane(tid >> 6); \
    unsigned char* ws = args.ws; asm volatile("" : "+s"(ws)); const int gw = vcu * 8 + wave; (void)gw; (void)lane; (void)tid;
#if MK_MULTI
    const int lo = args.ph_lo, hi = args.ph_hi;
#define IN(k) (lo <= (k) && (k) < hi)
#define SEAM(k) do { if (IN(k) && IN((k) + 1)) xcd_barrier(bar, MY_TID() == 0); } while (0)
#else
#define IN(k) true
#define SEAM(k) xcd_barrier(bar, MY_TID() == 0)
#endif
#define x_in ((const float*)args.in[0])
#define positions ((const int*)args.in[1])
#define xres (args.out)
#define ropeT ((float*)(ws + WS_ROPE))
#define posf ((float*)(ws + WS_POSF))
#define H ((bf16*)(ws + R_H))
#define CQKV ((bf16*)(ws + R_CQKV))
#define Qb ((bf16*)(ws + R_Q))
#define KV ((bf16*)(ws + R_KV))
#define KR ((bf16*)(ws + R_KR))
#define OA ((bf16*)(ws + R_OA))
#define DQKV ((bf16*)(ws + R_DQKV))
#define O01 ((bf16*)(ws + R_O01))
#define OB ((bf16*)(ws + R_OB))
#define GATES ((bf16*)(ws + R_GATES))
#define PAG ((bf16*)(ws + R_PAG))
#define MRG ((bf16*)(ws + R_MRG))
#define ACTD ((bf16*)(ws + R_ACTD))
#define WMOE ((bf16*)(ws + R_WMOE))
#define ACTM ((bf16*)(ws + R_ACTM))
#define WGU ((bf16*)(ws + WS_WGU))
#define WD ((bf16*)(ws + WS_WD))
#define TOPI ((int*)(ws + MOE_TOPI))
#define TOPW ((float*)(ws + MOE_TOPW))
#define BCNT ((int*)(ws + MOE_BCNT))
#define TOK ((int*)(ws + MOE_TOK))
#define WTL ((float*)(ws + MOE_WTL))
#define TEX ((int*)(ws + MOE_TEX))
#define NTR ((int*)(ws + MOE_NTR))

    if (IN(0)) { PHASE_LOCALS
        LAS float* scr = (LAS float*)(lds + wave * 16640);
        constexpr int I_IN = (DM / 64) * (DIN / 64), I_G = (DM / 64) * (2 * DM / 64), I_UQ = (CQ / 64) * (MLA_H * QHD / 64), I_UKV = (CKV / 64) * (MLA_H * 256 / 64), I_SQ = (DM / 64) * (DM / 64);
        constexpr int I_L = I_IN + I_G + I_UQ + I_UKV + 3 * I_SQ, I_FD = (DM / 64) * (FFD / 64);
        constexpr int NITEMS = NLAYER * I_L;
        for (int it = gw; it < NITEMS; it += NGW) {
            int r = it;
            if (r < NLAYER * I_L) { const int L = r / I_L; r -= L * I_L; bf16* wl = (bf16*)(ws + WS_W + L * W_LAYER);
                if (r < I_IN) { tr_item((const float*)args.in[3] + (size_t)L * DM * DIN, DM, DIN, (bf16*)((char*)wl + W_1A), (bf16*)((char*)wl + W_1B), DM, 1, 0, nullptr, r, scr, lane); continue; } r -= I_IN;
                if (r < I_G) { if (MLA_GG8 && (r % (2 * DM / 64)) < DM / 64) continue; tr_item((const float*)args.in[4] + (size_t)L * DM * 2 * DM, DM, 2 * DM, (bf16*)((char*)wl + W_1B), nullptr, DM, 0, 3 * DM, nullptr, r, scr, lane); continue; } r -= I_G;
                if (r < I_UQ) { if (MLA_UPF8) continue; tr_item((const float*)args.in[7] + (size_t)L * CQ * MLA_H * QHD, CQ, MLA_H * QHD, (bf16*)((char*)wl + W_UQ), nullptr, CQ, 0, 0, (const float*)args.in[5] + L * CQ, r, scr, lane); continue; } r -= I_UQ;
                if (r < I_UKV) { if (MLA_UPF8) continue; tr_item((const float*)args.in[8] + (size_t)L * CKV * MLA_H * 256, CKV, MLA_H * 256, (bf16*)((char*)wl + W_UKV), nullptr, CKV, 0, 0, (const float*)args.in[6] + L * CKV, r, scr, lane); continue; } r -= I_UKV;
                const int w = r / I_SQ; r -= w * I_SQ;
                if (MLA_GA8 && w == 0) continue;
                tr_item((const float*)args.in[20 + w] + (size_t)L * DM * DM, DM, DM, (bf16*)((char*)wl + (w == 0 ? W_A : (w == 1 ? W_B : W_O))), nullptr, DM, 0, 0, nullptr, r, scr, lane); continue; }
        }
        { __syncthreads();
            constexpr int I_B = (DM / 64) * (FFD / 256);
            constexpr int I_A8 = MLA_GA8 ? NLAYER * (DM / 64) * (DM / 256) : 0;
            constexpr int I_18 = MLA_G1F8 ? NLAYER * (DM / 64) * 4 : 0;
            constexpr int I_Q8 = (CQ / 64) * (MLA_H * QHD / 256), I_KV8 = (CKV / 64) * (MLA_H * 256 / 256), I_U8 = MLA_UPF8 ? NLAYER * (I_Q8 + I_KV8) : 0;
            constexpr int I_G8 = MLA_GG8 ? NLAYER * (DM / 64) * 4 : 0;
            for (int it = vcu; it < 3 * I_B + I_A8 + I_18 + I_U8 + I_G8; it += G) { int r = it;
                if (r >= 3 * I_B + I_A8 + I_18 + I_U8) { r -= 3 * I_B + I_A8 + I_18 + I_U8; const int Lg = r / ((DM / 64) * 4); r -= Lg * ((DM / 64) * 4);
                    tr_block8x((const float*)args.in[4] + (size_t)Lg * DM * 2 * DM, 2 * DM, (r >> 2) * 64, (r & 3) * 256, (unsigned char*)(ws + WS_W + Lg * W_LAYER + W_1B) + (size_t)3 * DM * DM * 2, DM, DM, nullptr, (LAS float*)lds, tid); continue; }
                if (r >= 3 * I_B + I_A8 + I_18) { r -= 3 * I_B + I_A8 + I_18; const int Lu = r / (I_Q8 + I_KV8); r -= Lu * (I_Q8 + I_KV8);
                    if (r < I_Q8) tr_block8x((const float*)args.in[7] + (size_t)Lu * CQ * MLA_H * QHD, MLA_H * QHD, (r / (MLA_H * QHD / 256)) * 64, (r % (MLA_H * QHD / 256)) * 256, (unsigned char*)(ws + WS_W + Lu * W_LAYER + W_UQ), CQ, MLA_H * QHD, (const float*)args.in[5] + Lu * CQ, (LAS float*)lds, tid);
                    else { r -= I_Q8; tr_block8x((const float*)args.in[8] + (size_t)Lu * CKV * MLA_H * 256, MLA_H * 256, (r / MLA_H) * 64, (r % MLA_H) * 256, (unsigned char*)(ws + WS_W + Lu * W_LAYER + W_UKV), CKV, MLA_H * 256, (const float*)args.in[6] + Lu * CKV, (LAS float*)lds, tid); }
                    continue; }
                if (r >= 3 * I_B + I_A8) { r -= 3 * I_B + I_A8; const int L1 = r / ((DM / 64) * 4); r -= L1 * ((DM / 64) * 4);
                    tr_block8x((const float*)args.in[3] + (size_t)L1 * DM * DIN, DIN, (r >> 2) * 64, (r & 3) * 256, (unsigned char*)(ws + WS_W + L1 * W_LAYER + W_1A), DM, 832, nullptr, (LAS float*)lds, tid); continue; }
                if (r >= 3 * I_B) { r -= 3 * I_B; const int La = r / ((DM / 64) * (DM / 256)); r -= La * ((DM / 64) * (DM / 256));
                    tr_bitem8((const float*)args.in[20] + (size_t)La * DM * DM, DM, DM, (unsigned char*)(ws + WS_W + La * W_LAYER + W_A), DM, 0, 0, r, (LAS float*)lds, tid); continue; }
                if (r < I_B) { if (FP8_UPD) tr_bitem8((const float*)args.in[24], DM, FFD, (unsigned char*)WGU, DM, 2, 0, r, (LAS float*)lds, tid); else tr_bitem((const float*)args.in[24], DM, FFD, WGU, DM, 2, 0, r, (LAS float*)lds, tid); continue; } r -= I_B;
                if (r < I_B) { if (FP8_UPD) tr_bitem8((const float*)args.in[25], DM, FFD, (unsigned char*)WGU, DM, 3, 0, r, (LAS float*)lds, tid); else tr_bitem((const float*)args.in[25], DM, FFD, WGU, DM, 3, 0, r, (LAS float*)lds, tid); continue; } r -= I_B;
                if (FP8_DND) tr_bitem8((const float*)args.in[26], FFD, DM, (unsigned char*)WD, FFD, 0, 0, r, (LAS float*)lds, tid); else tr_bitem((const float*)args.in[26], FFD, DM, WD, FFD, 0, 0, r, (LAS float*)lds, tid); } }
        for (int i = gw * 64 + lane; i < NLAYER * 24576; i += NGW * 64) { const int L = i / 24576, j = i % 24576;
            if (MLA_G1F8) { if (j < 12288) *(u32x4*)((char*)ws + WS_W + L * W_LAYER + W_1A + (size_t)832 * DM + (size_t)j * 16) = (u32x4){0u, 0u, 0u, 0u}; }
            else *(u32x4*)((char*)ws + WS_W + L * W_LAYER + W_1A + (size_t)832 * DM * 2 + (size_t)j * 16) = (u32x4){0u, 0u, 0u, 0u}; }
        for (int i = gw * 64 + lane; i < T * 32; i += NGW * 64) { const int t = i >> 5, f = i & 31; const int p = positions[t];
            const double ang = (double)p * INV_FREQ[f]; const double rev = ang * 0.15915494309189533577; const float fr = (float)(rev - floor(rev));
            ropeT[2 * i] = __builtin_amdgcn_cosf(fr); ropeT[2 * i + 1] = __builtin_amdgcn_sinf(fr);
            if (f == 0) posf[t] = (float)p; }
        for (int j = gw; j < NB * (SEQ / 64); j += NGW) { const float p = (float)positions[j * 64 + lane]; const float mn = -wave_max(-p), mx = wave_max(p);
            const float dd = p - (float)lane; const bool contig = (wave_max(dd) == -wave_max(-dd));
            if (lane == 0) { ((float*)(ws + WS_TMM))[2 * j] = mn; ((float*)(ws + WS_TMM))[2 * j + 1] = mx; ((float*)(ws + WS_TFL))[j] = contig ? 1.f : 0.f; } }
        for (int j = gw; j < NB * (SEQ / 256); j += NGW) { float mn = 3.0e38f, mx = -3.0e38f;
#pragma unroll
            for (int q = 0; q < 4; ++q) { const float p = (float)positions[j * 256 + q * 64 + lane]; mn = fminf(mn, p); mx = fmaxf(mx, p); }
            mn = -wave_max(-mn); mx = wave_max(mx);
            if (lane == 0) { ((float*)(ws + WS_QMM))[2 * j] = mn; ((float*)(ws + WS_QMM))[2 * j + 1] = mx; } }
    }
#if MK_MULTI
    SEAM(0);
#endif

    for (int L = 0; L < NLAYER; ++L) {
        const int pb = 1 + L * NPH_LAYER;
#define WL(off) ((const bf16*)(ws + WS_W + (size_t)L * W_LAYER + (off)))
#define W1A WL(W_1A)
#define W1B WL(W_1B)
#define WUQ WL(W_UQ)
#define WUKV WL(W_UKV)
#define WA WL(W_A)
#define WB WL(W_B)
#define WO WL(W_O)
#define xcur ((L == 0) ? x_in : (const float*)xres)
        const bool moe_layer = (L & 1) != 0;

        if (IN(pb + 0)) { PHASE_LOCALS const float* g = (const float*)args.in[2] + L * DM;
            for (int t = gw; t < T; t += 4 * NGW) { f32x4 v[4][4];
#pragma unroll
                for (int i = 0; i < 4; ++i) norm_load(xcur + (size_t)(t + i * NGW) * DM, lane, v[i]);
#pragma unroll
                for (int i = 0; i < 4; ++i) { norm_fin(g, H + (size_t)(t + i * NGW) * DM, lane, v[i]);
                    if (MLA_G1F8) { unsigned* o4 = (unsigned*)(ws + R_OA + 32 * MiB + (size_t)(t + i * NGW) * DM) + lane;
#pragma unroll
                        for (int j = 0; j < 4; ++j) o4[64 * j] = pk4_fp8(v[i][j].x, v[i][j].y, v[i][j].z, v[i][j].w); } } } }
        SEAM(pb + 0);
        if (IN(pb + 1)) { PHASE_LOCALS pg8::StaticOrder S; S.init(T, 1024, G, bx);
            pg8::EpiBf16G E{CQKV, 1024, 7, 0, 3, nullptr, (LAS float*)(lds + 131072), (float*)(ws + WS_SSQ), 0, MLA_UPF8 ? (unsigned char*)(ws + R_OA) : nullptr};
            if (MLA_G1F8) { pg8::ProbPlain8 P{(const unsigned char*)(ws + R_OA + 32 * MiB), DM, (const unsigned char*)W1A, DM, DM, SC_ONE, SC_W}; pg8::gemm_phase(lds, P, S, E, tid); }
            else { pg8::ProbPlain P{H, DM, W1A, DM, DM}; pg8::gemm_phase(lds, P, S, E, tid); } }
        SEAM(pb + 1);
        if (IN(pb + 3)) { PHASE_LOCALS
            { const float* g_kr = (const float*)args.in[12] + L * ROPE;
              for (int t = gw; t < T; t += 4 * NGW) { const int tt[4] = {t, t + NGW, t + 2 * NGW, t + 3 * NGW}; kr_rows<4>(CQKV, KR, tt, g_kr, ropeT, lane); } }
            { pg8::ProbPlain P{CQKV, 1024, WUQ, CQ, CQ}; pg8::StaticOrder S; S.init(T, MLA_H * QHD, G, bx); pg8::EpiBf16M E{Qb, MLA_H * QHD, 6, (const bf16*)(ws + WS_SSQ), 0, nullptr, 0}; if (MLA_UPF8) { pg8::ProbPlain8 P8{(const unsigned char*)(ws + R_OA), 1024, (const unsigned char*)WUQ, CQ, CQ, SC_ONE, SC_W}; pg8::gemm_phase(lds, P8, S, E, tid); } else pg8::gemm_phase(lds, P, S, E, tid); }
            { pg8::ProbPlain P{CQKV + CQ, 1024, WUKV, CKV, CKV}; pg8::StaticOrder S; S.init(T, MLA_H * 256, G, bx);
              pg8::EpiBf16G E{KV, MLA_H * 256, 5, 0, 0, (const float*)args.in[11] + L * NOPE, (LAS float*)(lds + 131072), (float*)(ws + WS_SSQ), MLA_FP8, nullptr}; if (MLA_UPF8) { pg8::ProbPlain8 P8{(const unsigned char*)(ws + R_OA) + CQ, 1024, (const unsigned char*)WUKV, CKV, CKV, SC_ONE, SC_W}; pg8::gemm_phase(lds, P8, S, E, tid); } else pg8::gemm_phase(lds, P, S, E, tid);
              if (MLA_FP8) { __builtin_amdgcn_fence(__ATOMIC_ACQUIRE, "agent");
                constexpr int nM_ = T / 256, nN_ = MLA_H, nwg_ = nM_ * nN_;
                for (int i = 0; i * G + bx < nwg_; ++i) { pg8::Unit u;
                    { int wgid = i * G + bx; { const int q = nwg_ / pg8::NXCD, r = nwg_ % pg8::NXCD, xcd = wgid % pg8::NXCD, off = wgid / pg8::NXCD; wgid = (xcd < r ? xcd * (q + 1) : r * (q + 1) + (xcd - r) * q) + off; }
                      const int nig = pg8::WGM * nN_, gid = wgid / nig, fm = gid * pg8::WGM, gsz = (nM_ - fm) < pg8::WGM ? (nM_ - fm) : pg8::WGM;
                      u.pm = fm + ((wgid % nig) % gsz); u.pn = (wgid % nig) / gsz; }
                    { const int h = u.pn, row0 = u.pm * 256 + (wave & 3) * 64, ti = ((row0 / SEQ) * MLA_H + h) * (SEQ / 64) + (row0 % SEQ) / 64;
                    const bf16* srcv = KV + (size_t)row0 * (MLA_H * 256) + h * 256 + NOPE + 8 * (lane & 15);
                    unsigned char* dst = ws + R_VT8 + (size_t)ti * 8192 + (size_t)(8 * (lane & 15)) * 64;
#pragma unroll
                    for (int I2 = 0; I2 < 2; ++I2) { const int I = 2 * (wave >> 2) + I2; u32x4 r4[4];
#pragma unroll
                        for (int kk = 0; kk < 4; ++kk) r4[kk] = *(const u32x4*)(srcv + (size_t)(16 * I + 4 * (lane >> 4) + kk) * (MLA_H * 256));
                        float f0[8], f1[8], f2[8], f3[8]; unpack8(r4[0], f0); unpack8(r4[1], f1); unpack8(r4[2], f2); unpack8(r4[3], f3);
                        const int q = 4 * I + (lane >> 4), pos = 32 * (q & 1) + 16 * (q >> 3) + 4 * ((q & 7) >> 1);
#pragma unroll
                        for (int c = 0; c < 8; ++c) *(unsigned*)(dst + c * 64 + pos) = pk4_fp8(4.0f * f0[c], 4.0f * f1[c], 4.0f * f2[c], 4.0f * f3[c]); } } }  } }
        }
        SEAM(pb + 3);
        if (IN(pb + 5)) { PHASE_LOCALS
            constexpr int NU = NB * MLA_H * (SEQ / 256);
            for (int u = vcu; u < NU; u += G) { const int b = u / (MLA_H * 32), h = (u / 32) % MLA_H, qb = u % 32; const size_t r0 = (size_t)b * SEQ, rq = r0 + (size_t)qb * 256;
                if (MLA_FP8) att::attn_unit_mla8(Qb + rq * (MLA_H * QHD) + h * QHD, MLA_H * QHD, (const unsigned char*)(KV + r0 * (MLA_H * 256) + h * 256), MLA_H * 512, (const unsigned char*)KR + r0 * 64,
                                              ws + R_VT8 + (size_t)(b * MLA_H + h) * (SEQ / 64) * 8192, MLA_GA8 ? (bf16*)((unsigned char*)OA + rq * DM + h * MLAV) : OA + rq * DM + h * MLAV, DM, SEQ, (att::lptr)lds, wave_s, (const float*)args.in[9] + L * NOPE, (const float*)args.in[10] + L * ROPE, ropeT + rq * 64);
                else att::attn_unit_dma<QHD, false>(Qb + rq * (MLA_H * QHD) + h * QHD, MLA_H * QHD, KV + r0 * (MLA_H * 256) + h * 256, MLA_H * 256, KR + r0 * 64, KV + r0 * (MLA_H * 256) + h * 256 + NOPE, MLA_H * 256,
                                              OA + rq * DM + h * MLAV, DM, nullptr, nullptr, 0.f, 0.07216878364870322f, SEQ, (att::lptr)lds, wave_s,
                                              (const float*)args.in[9] + L * NOPE, (const float*)args.in[10] + L * ROPE, ropeT + rq * 64, nullptr, nullptr); }
        }
        SEAM(pb + 5);
        if (IN(pb + 6)) { PHASE_LOCALS
            { const float l1 = wave_sum(((const float*)args.in[15])[L * DHD + lane] * ((const float*)args.in[16])[L * DHD + lane]);
              const float l2 = wave_sum(((const float*)args.in[17])[L * DHD + lane] * ((const float*)args.in[18])[L * DHD + lane]);
              float c08 = 0.8f, c1 = 1.0f; asm volatile("" : "+v"(c08), "+v"(c1));
              const float lam_init = c08 - 0.6f * expf(-0.3f * (float)L); MISC[21] = __float_as_uint(expf(l1) - expf(l2) + lam_init); MISC[22] = __float_as_uint(c1 - lam_init); }
            pg8::ProbPlain P{H, DM, W1B, DM, DM}; pg8::StaticOrder S; S.init(T, 3 * DM, G, bx);
            pg8::EpiBf16G E{DQKV, 3 * DM, 4, 4, 8, (const float*)args.in[14] + L * DHD, (LAS float*)(lds + 131072), nullptr, 0, nullptr};
            pg8::gemm_phase(lds, P, S, E, tid); }
        SEAM(pb + 6);
        if (IN(pb + 8)) { PHASE_LOCALS
            constexpr int NU = NB * DH * (SEQ / 256);
            const float gq = wave_max(fabsf(((const float*)args.in[13])[L * DHD + lane])), gk = wave_max(fabsf(((const float*)args.in[14])[L * DHD + lane]));
            MISC[20] = __float_as_uint(2.0f * (8.0f * gq * gk * 1.02f) + 27.0f); MISC[24] = __float_as_uint(8.0f * gq * gk * 1.02f);
            MISC[23] = (8.0f * gq * gk * 1.02f * 1.4426950408889634f <= 60.0f) ? 1u : 0u;
            unsigned* qhead = (unsigned*)(ws + WS_CTL) + CW_QUEUE + 64 * L;
            const float* tmm = (const float*)(ws + WS_TMM); const float* qmm = (const float*)(ws + WS_QMM);
            for (;;) {
                const int tq = fresh_tid(wave_s), lq = tq & 63;
                if (tq == 0) MISC[16] = __hip_atomic_fetch_add(qhead, 1u, __ATOMIC_RELAXED, __HIP_MEMORY_SCOPE_AGENT);
                __syncthreads();
                const int i = __builtin_amdgcn_readfirstlane((int)MISC[16]);
                __syncthreads();
                if (i >= NU) break;
                const int h = 7 - (i >> 7), r = i & 127, b = r >> 5, qb = r & 31; const size_t r0 = (size_t)b * SEQ, rq = r0 + (size_t)qb * 256;
                const float slope = exp2f(-(float)(h + 1));
                const float qmn = qmm[2 * (b * 32 + qb)], qmx = qmm[2 * (b * 32 + qb) + 1];
                { const int row = tq >> 1, hf = tq & 1; const float* gqp = (const float*)args.in[13] + L * DHD + hf * 32;
#pragma unroll
                  for (int c = 0; c < 2; ++c) { const bf16* qp = DQKV + (rq + row) * (3 * DM) + (h * 2 + c) * DHD + hf * 32; float sq = 0.f, dt = 0.f;
#pragma unroll
                      for (int p = 0; p < 4; ++p) { float qf[8], kf[8]; unpack8(*(const u32x4*)(qp + 8 * p), qf); unpack8(*(const u32x4*)(qp + DM + 8 * p), kf);
#pragma unroll
                          for (int e = 0; e < 8; ++e) { sq += qf[e] * qf[e]; dt += qf[e] * gqp[8 * p + e] * kf[e]; } }
                      sq += xshfl<1>(sq); dt += xshfl<1>(dt);
                      const float sii = dt * (1.0f / sqrtf(sq * (1.f / DHD) + EPS)) * 0.125f;
                      const float wmn = -wave_max(-sii); if (lq == 0) MISC[40 + 8 * c + (tq >> 6)] = __float_as_uint(wmn); } }
                __syncthreads();
                int t_lo_c[2], t_hi_c[2];
#pragma unroll
                for (int c = 0; c < 2; ++c) { float smin = __uint_as_float(MISC[40 + 8 * c]);
#pragma unroll
                    for (int w = 1; w < 8; ++w) smin = fminf(smin, __uint_as_float(MISC[40 + 8 * c + w]));
                    const float Bs = __uint_as_float(MISC[24]); const float margin = fminf(__uint_as_float(MISC[20]), Bs + 27.25f - smin);
                    unsigned long long m0, m1;
                    { const float k0n = tmm[2 * (b * 128 + lq)], k0x = tmm[2 * (b * 128 + lq) + 1], k1n = tmm[2 * (b * 128 + 64 + lq)], k1x = tmm[2 * (b * 128 + 64 + lq) + 1];
                      const float d0 = fmaxf(0.f, fmaxf(k0n - qmx, qmn - k0x)), d1 = fmaxf(0.f, fmaxf(k1n - qmx, qmn - k1x));
                      m0 = __ballot(slope * d0 <= margin); m1 = __ballot(slope * d1 <= margin); }
                    int t_lo = m0 ? (int)__builtin_ctzll(m0) : 64 + (int)__builtin_ctzll(m1), t_hi = m1 ? 127 - (int)__builtin_clzll(m1) : 63 - (int)__builtin_clzll(m0);
                    if (((t_hi - t_lo + 1) & 1) != 0) { if (t_hi < 127) ++t_hi; else --t_lo; }
                    t_lo_c[c] = __builtin_amdgcn_readfirstlane(t_lo); t_hi_c[c] = __builtin_amdgcn_readfirstlane(t_hi); }
                { LAS int* tc = (LAS int*)(lds + att::D_OFF_TT); LAS float* tp = (LAS float*)(lds + att::D_OFF_TT + 512); const float* tfl = (const float*)(ws + WS_TFL);
#pragma unroll
                  for (int q2 = 0; q2 < 2; ++q2) { const int tj = lq + 64 * q2; const float kn = tmm[2 * (b * 128 + tj)], kx = tmm[2 * (b * 128 + tj) + 1];
                      const int cl = (tfl[b * 128 + tj] != 0.f) ? ((kx <= qmn) ? 1 : ((kn >= qmx) ? 2 : 0)) : 0; tc[tj] = cl; tp[tj] = kn; } }
                const bool fixref = __builtin_amdgcn_readfirstlane((int)MISC[23]) != 0;
                { const int hc = h * 2; const int t_lo = t_lo_c[0], t_hi = t_hi_c[0]; const size_t k0 = r0 + (size_t)t_lo * 64;
                  if (fixref) att::attn_unit_dma<DHD, true, 1, true>(DQKV + rq * (3 * DM) + hc * DHD, 3 * DM, DQKV + k0 * (3 * DM) + DM + hc * DHD, 3 * DM, nullptr, DQKV + k0 * (3 * DM) + 2 * DM + h * 128, 3 * DM,
                                             OB + rq * DM + h * 128, DM, posf + rq, posf + k0, -slope * 1.4426950408889634f, 0.125f, (t_hi - t_lo + 1) * 64, (att::lptr)lds, wave_s,
                                             (const float*)args.in[13] + L * DHD, nullptr, nullptr, (const LAS int*)(lds + att::D_OFF_TT) + t_lo, (const LAS float*)(lds + att::D_OFF_TT + 512) + t_lo);
                  else att::attn_unit_dma<DHD, true, 1>(DQKV + rq * (3 * DM) + hc * DHD, 3 * DM, DQKV + k0 * (3 * DM) + DM + hc * DHD, 3 * DM, nullptr, DQKV + k0 * (3 * DM) + 2 * DM + h * 128, 3 * DM,
                                             OB + rq * DM + h * 128, DM, posf + rq, posf + k0, -slope * 1.4426950408889634f, 0.125f, (t_hi - t_lo + 1) * 64, (att::lptr)lds, wave_s,
                                             (const float*)args.in[13] + L * DHD, nullptr, nullptr, (const LAS int*)(lds + att::D_OFF_TT) + t_lo, (const LAS float*)(lds + att::D_OFF_TT + 512) + t_lo); }
                { const int hc = h * 2 + 1; const int t_lo = t_lo_c[1], t_hi = t_hi_c[1]; const size_t k0 = r0 + (size_t)t_lo * 64; const float lam = __uint_as_float(MISC[21]), omli = __uint_as_float(MISC[22]);
                  if (fixref) att::attn_unit_dma<DHD, true, 2, true>(DQKV + rq * (3 * DM) + hc * DHD, 3 * DM, DQKV + k0 * (3 * DM) + DM + hc * DHD, 3 * DM, nullptr, DQKV + k0 * (3 * DM) + 2 * DM + h * 128, 3 * DM,
                                             OB + rq * DM + h * 128, DM, posf + rq, posf + k0, -slope * 1.4426950408889634f, 0.125f, (t_hi - t_lo + 1) * 64, (att::lptr)lds, wave_s,
                                             (const float*)args.in[13] + L * DHD, nullptr, nullptr, (const LAS int*)(lds + att::D_OFF_TT) + t_lo, (const LAS float*)(lds + att::D_OFF_TT + 512) + t_lo,
                                             (const float*)args.in[19] + L * 128, lam, omli);
                  else att::attn_unit_dma<DHD, true, 2>(DQKV + rq * (3 * DM) + hc * DHD, 3 * DM, DQKV + k0 * (3 * DM) + DM + hc * DHD, 3 * DM, nullptr, DQKV + k0 * (3 * DM) + 2 * DM + h * 128, 3 * DM,
                                             OB + rq * DM + h * 128, DM, posf + rq, posf + k0, -slope * 1.4426950408889634f, 0.125f, (t_hi - t_lo + 1) * 64, (att::lptr)lds, wave_s,
                                             (const float*)args.in[13] + L * DHD, nullptr, nullptr, (const LAS int*)(lds + att::D_OFF_TT) + t_lo, (const LAS float*)(lds + att::D_OFF_TT + 512) + t_lo,
                                             (const float*)args.in[19] + L * 128, lam, omli); } }
        }
        SEAM(pb + 8);
#if MK_MULTI
        SEAM(pb + 9);
#endif
        if (IN(pb + 10)) { PHASE_LOCALS
            if (MLA_GG8) { pg8::StaticOrder S; S.init(T, DM, G, bx);
                { pg8::ProbPlain8 P{(const unsigned char*)(ws + R_OA + 32 * MiB), DM, (const unsigned char*)(W1B + (size_t)3 * DM * DM), DM, DM, SC_ONE, SC_W}; pg8::EpiBf16M E{GATES, 2 * DM, 1, nullptr, 0, nullptr, 0}; pg8::gemm_phase(lds, P, S, E, tid); }
                { pg8::ProbPlain P{H, DM, W1B + (size_t)4 * DM * DM, DM, DM}; pg8::EpiBf16M E{GATES + DM, 2 * DM, 1, nullptr, 0, nullptr, 0}; pg8::gemm_phase(lds, P, S, E, tid); } }
            else { pg8::ProbPlain P{H, DM, W1B + (size_t)3 * DM * DM, DM, DM}; pg8::StaticOrder S; S.init(T, 2 * DM, G, bx); pg8::EpiBf16M E{GATES, 2 * DM, 1, nullptr, 0, nullptr, 0};
                pg8::gemm_phase(lds, P, S, E, tid); } }
#if MK_MULTI || !MLA_GG8
        SEAM(pb + 10);
#endif
        if (IN(pb + 11)) { PHASE_LOCALS pg8::StaticOrder S; S.init(T, DM, G, bx); pg8::EpiBf16M E{PAG, DM, 2, GATES, 2 * DM, nullptr, 0};
            if (MLA_GA8) { pg8::ProbPlain8 P{(const unsigned char*)OA, DM, (const unsigned char*)WA, DM, DM, SC_OA, SC_W}; pg8::gemm_phase(lds, P, S, E, tid); }
            else { pg8::ProbPlain P{OA, DM, WA, DM, DM}; pg8::gemm_phase(lds, P, S, E, tid); } }
#if MK_MULTI || !MLA_GG8
        SEAM(pb + 11);
#endif
        if (IN(pb + 12)) { PHASE_LOCALS pg8::ProbPlain P{OB, DM, WB, DM, DM}; pg8::StaticOrder S; S.init(T, DM, G, bx); pg8::EpiBf16M E{MRG, DM, 3, GATES + DM, 2 * DM, PAG, DM};
            pg8::gemm_phase(lds, P, S, E, tid); }
        SEAM(pb + 12);
        if (IN(pb + 13)) { PHASE_LOCALS pg8::ProbPlain P{MRG, DM, WO, DM, DM}; pg8::StaticOrder S; S.init(T, DM, G, bx); pg8::EpiF32Res E{xcur, xres, DM};
            pg8::gemm_phase(lds, P, S, E, tid); }
        SEAM(pb + 13);
        if (IN(pb + 14)) { PHASE_LOCALS const float* g = (const float*)args.in[23] + L * DM;
            if (!moe_layer) { for (int t = gw; t < T; t += 4 * NGW) { f32x4 v[4][4];
#pragma unroll
                for (int i = 0; i < 4; ++i) norm_load(xres + (size_t)(t + i * NGW) * DM, lane, v[i]);
#pragma unroll
                for (int i = 0; i < 4; ++i) { if (FP8_UPD) norm_fin8(g, (unsigned char*)H + (size_t)(t + i * NGW) * DM, lane, v[i]); else norm_fin(g, H + (size_t)(t + i * NGW) * DM, lane, v[i]); } } }
            else {
                const int j = L >> 1;
                { LAS float* scr = (LAS float*)lds;
                  constexpr int I_GU = (DM / 64) * (FFE / 256), I_D = (FFE / 64) * (DM / 256), I_E = 2 * I_GU + I_D;
                  for (int it = vcu; it < NEXP * I_E; it += G) { const int e = it / I_E; int r = it - e * I_E;
                      char* wgu = (char*)WMOE + (size_t)e * WMOE_GU; char* wd = (char*)WMOE + (size_t)NEXP * WMOE_GU + (size_t)e * WMOE_D;
                      if (r < I_GU) { if (FP8_UP) tr_bitem8((const float*)args.in[28] + ((size_t)j * NEXP + e) * DM * FFE, DM, FFE, (unsigned char*)wgu, DM, 2, 0, r, scr, tid); else tr_bitem((const float*)args.in[28] + ((size_t)j * NEXP + e) * DM * FFE, DM, FFE, (bf16*)wgu, DM, 2, 0, r, scr, tid); continue; } r -= I_GU;
                      if (r < I_GU) { if (FP8_UP) tr_bitem8((const float*)args.in[29] + ((size_t)j * NEXP + e) * DM * FFE, DM, FFE, (unsigned char*)wgu, DM, 3, 0, r, scr, tid); else tr_bitem((const float*)args.in[29] + ((size_t)j * NEXP + e) * DM * FFE, DM, FFE, (bf16*)wgu, DM, 3, 0, r, scr, tid); continue; } r -= I_GU;
                      if (FP8_DN) tr_bitem8((const float*)args.in[30] + ((size_t)j * NEXP + e) * FFE * DM, FFE, DM, (unsigned char*)wd, FFE, 0, 0, r, scr, tid); else tr_bitem((const float*)args.in[30] + ((size_t)j * NEXP + e) * FFE * DM, FFE, DM, (bf16*)wd, FFE, 0, 0, r, scr, tid); } }
                __syncthreads();
                LAS float* wr_l = (LAS float*)lds; LAS int* sel = (LAS int*)(lds + 32768);
                { const float* wr = (const float*)args.in[27] + (size_t)j * DM * NEXP;
                  for (int i = tid; i < DM * NEXP; i += 512) wr_l[(i & 7) * DM + (i >> 3)] = wr[i]; }
                __syncthreads();
                for (int c = bx; c < T / 128; c += G) {
                    for (int rr = 0; rr < 16; ++rr) { const int tl = wave * 16 + rr, t = c * 128 + tl; f32x4 v[4]; norm_load(xres + (size_t)t * DM, lane, v); if (FP8_UP) norm_fin8(g, (unsigned char*)H + (size_t)t * DM, lane, v); else norm_fin(g, H + (size_t)t * DM, lane, v);
                        float lg[NEXP];
#pragma unroll
                        for (int e = 0; e < NEXP; ++e) { float s = 0.f;
#pragma unroll
                            for (int q = 0; q < 4; ++q) { const f32x4 w = *(const LAS f32x4*)(wr_l + e * DM + 4 * lane + 256 * q); s += (v[q].x * w.x + v[q].y * w.y) + (v[q].z * w.z + v[q].w * w.w); }
                            lg[e] = wave_sum(s); }
                        int i0 = 0; float v0 = lg[0];
#pragma unroll
                        for (int e = 1; e < NEXP; ++e) if (lg[e] > v0) { v0 = lg[e]; i0 = e; }
                        int i1 = -1; float v1 = -3.0e38f;
#pragma unroll
                        for (int e = 0; e < NEXP; ++e) if (e != i0 && lg[e] > v1) { v1 = lg[e]; i1 = e; }
                        const float w0 = 1.0f / (1.0f + expf(v1 - v0));
                        if (lane == 0) { TOPI[2 * t] = i0; TOPI[2 * t + 1] = i1; TOPW[2 * t] = w0; TOPW[2 * t + 1] = 1.0f - w0; sel[2 * tl] = i0; sel[2 * tl + 1] = i1; } }
                    __syncthreads();
                    if (tid < 16) { const int p = tid >> 3, e = tid & 7; int n = 0; for (int i = 0; i < 128; ++i) n += (sel[2 * i + p] == e) ? 1 : 0; BCNT[c * 16 + tid] = n; }
                    __syncthreads();
                }
            }
        }
        SEAM(pb + 14);
        if (!moe_layer) {
            if (IN(pb + 15)) { PHASE_LOCALS pg8::StaticOrder S; S.init(T, 2 * FFD, G, bx);
                if (FP8_UPD && FP8_DND) { pg8::ProbPlain8 P{(const unsigned char*)H, DM, (const unsigned char*)WGU, DM, DM, SC_ONE, SC_W}; pg8::EpiSwiGLU8 E{(unsigned char*)ACTD, FFD}; pg8::gemm_phase(lds, P, S, E, tid); }
                else if (FP8_UPD) { pg8::ProbPlain8 P{(const unsigned char*)H, DM, (const unsigned char*)WGU, DM, DM, SC_ONE, SC_W}; pg8::EpiSwiGLU E{ACTD, FFD}; pg8::gemm_phase(lds, P, S, E, tid); }
                else if (FP8_DND) { pg8::ProbPlain P{H, DM, WGU, DM, DM}; pg8::EpiSwiGLU8 E{(unsigned char*)ACTD, FFD}; pg8::gemm_phase(lds, P, S, E, tid); }
                else { pg8::ProbPlain P{H, DM, WGU, DM, DM}; pg8::EpiSwiGLU E{ACTD, FFD}; pg8::gemm_phase(lds, P, S, E, tid); } }
            SEAM(pb + 15);
            if (IN(pb + 16)) { PHASE_LOCALS pg8::StaticOrder S; S.init(T, DM, G, bx); pg8::EpiF32Res E{xres, xres, DM};
                if (FP8_DND) { pg8::ProbPlain8 P{(const unsigned char*)ACTD, FFD, (const unsigned char*)WD, FFD, FFD, SC_ACT, SC_W}; pg8::gemm_phase(lds, P, S, E, tid); }
                else { pg8::ProbPlain P{ACTD, FFD, WD, FFD, FFD}; pg8::gemm_phase(lds, P, S, E, tid); } }
            if (L + 1 < NLAYER) { SEAM(pb + 16); }
        } else {
            if (IN(pb + 15)) { PHASE_LOCALS
                LAS int* cnt_l = (LAS int*)lds;
                LAS int* tot_l = (LAS int*)(lds + 16384);
                LAS int* sel = (LAS int*)(lds + 16384 + 256);
                for (int i = tid; i < 256 * 16; i += 512) cnt_l[i] = BCNT[i];
                __syncthreads();
                if (tid < 16) { int s = 0; for (int c = 0; c < 256; ++c) s += cnt_l[c * 16 + tid]; tot_l[tid] = s; }
                __syncthreads();
                if (tid < 16) { const int p = tid >> 3, e = tid & 7; int b = 0; for (int e2 = 0; e2 < e; ++e2) b += (tot_l[p * 8 + e2] + 255) & ~255; tot_l[16 + tid] = b; }
                __syncthreads();
                for (int c = bx; c < T / 128; c += G) {
                    if (tid < 16) { int s = 0; for (int c2 = 0; c2 < c; ++c2) s += cnt_l[c2 * 16 + tid]; tot_l[32 + tid] = s; }
                    if (tid < 128) { sel[2 * tid] = TOPI[2 * (c * 128 + tid)]; sel[2 * tid + 1] = TOPI[2 * (c * 128 + tid) + 1]; }
                    __syncthreads();
                    if (tid < 128) { const int t = c * 128 + tid;
#pragma unroll
                        for (int p = 0; p < 2; ++p) { const int e = sel[2 * tid + p]; int rank = 0; for (int i = 0; i < tid; ++i) rank += (sel[2 * i + p] == e) ? 1 : 0;
                            const int pos = tot_l[16 + p * 8 + e] + tot_l[32 + p * 8 + e] + rank; TOK[p * NPMAX + pos] = t; WTL[p * NPMAX + pos] = TOPW[2 * t + p]; } }
                    if (c < 16) { const int p = c >> 3; const int b0 = tot_l[16 + c] + tot_l[c], b1 = tot_l[16 + c] + ((tot_l[c] + 255) & ~255);
                        for (int i = b0 + tid; i < b1; i += 512) { TOK[p * NPMAX + i] = -1; WTL[p * NPMAX + i] = 0.f; } }
                    if (c == 0) { if (tid < 2) NTR[tid] = (tot_l[16 + tid * 8 + 7] + ((tot_l[tid * 8 + 7] + 255) & ~255)) >> 8;
                        if (tid < 2 * 256) { const int p = tid >> 8, jt = tid & 255; int e = 0; for (int e2 = 1; e2 < NEXP; ++e2) if (jt * 256 >= tot_l[16 + p * 8 + e2]) e = e2; TEX[p * 256 + jt] = e; } }
                    __syncthreads();
                }
            }
            SEAM(pb + 15);
            const int jm = L >> 1;
            for (int p = 0; p < 2; ++p) {
                if (IN(pb + 16 + 2 * p)) { PHASE_LOCALS const int ntr = __builtin_amdgcn_readfirstlane(NTR[p]);
                    pg8::StaticOrder S; S.init(ntr * 256, 2 * FFE, G, bx);
                    if (FP8_UP && FP8_DN) { pg8::ProbMoeUp8 P{(const unsigned char*)H, DM, (const unsigned char*)WMOE, DM, DM, (size_t)WMOE_GU, TOK + p * NPMAX, TEX + p * 256, SC_ONE, SC_W}; pg8::EpiSwiGLU8 E{(unsigned char*)ACTM + (size_t)p * NPMAX * FFE, FFE}; pg8::gemm_phase(lds, P, S, E, tid); }
                    else if (FP8_UP) { pg8::ProbMoeUp8 P{(const unsigned char*)H, DM, (const unsigned char*)WMOE, DM, DM, (size_t)WMOE_GU, TOK + p * NPMAX, TEX + p * 256, SC_ONE, SC_W}; pg8::EpiSwiGLU E{ACTM, FFE}; pg8::gemm_phase(lds, P, S, E, tid); }
                    else if (FP8_DN) { pg8::ProbMoeUp P{H, DM, WMOE, DM, DM, (size_t)WMOE_GU / 2, TOK + p * NPMAX, TEX + p * 256}; pg8::EpiSwiGLU8 E{(unsigned char*)ACTM, FFE}; pg8::gemm_phase(lds, P, S, E, tid); }
                    else { pg8::ProbMoeUp P{H, DM, WMOE, DM, DM, (size_t)WMOE_GU / 2, TOK + p * NPMAX, TEX + p * 256}; pg8::EpiSwiGLU E{ACTM, FFE}; pg8::gemm_phase(lds, P, S, E, tid); } }
            }
            static_assert(FP8_UP && FP8_DN, "both routing slots' activations (e4m3) share the activation region");
            SEAM(pb + 16);
            for (int p = 0; p < 2; ++p) {
                if (IN(pb + 17 + 2 * p)) { PHASE_LOCALS const int ntr = __builtin_amdgcn_readfirstlane(NTR[p]);
                    pg8::StaticOrder S; S.init(ntr * 256, DM, G, bx); pg8::EpiMoeDown E{xres, DM, TOK + p * NPMAX, WTL + p * NPMAX};
                    if (FP8_DN) { pg8::ProbMoeDown8 P{(const unsigned char*)ACTM + (size_t)p * NPMAX * FFE, FFE, (const unsigned char*)WMOE + (size_t)NEXP * WMOE_GU, FFE, FFE, (size_t)WMOE_D, TEX + p * 256, SC_ACT, SC_W}; pg8::gemm_phase(lds, P, S, E, tid); }
                    else { pg8::ProbMoeDown P{ACTM, FFE, (const bf16*)((const char*)WMOE + (size_t)NEXP * WMOE_GU), FFE, FFE, (size_t)WMOE_D / 2, TEX + p * 256}; pg8::gemm_phase(lds, P, S, E, tid); } }
                if (p == 0 || L + 1 < NLAYER) SEAM(pb + 17 + 2 * p);
            }
            (void)jm;
        }
    }
#undef IN
#undef SEAM
}

#ifndef DBG_STOP
#define DBG_STOP (NPHASES - 1)
#endif
#ifndef DBG_DUMP_OFF
#define DBG_DUMP_OFF 0
#endif
__global__ void dbg_dump(const unsigned short* src, float* out, size_t n) { for (size_t i = (size_t)blockIdx.x * blockDim.x + threadIdx.x; i < n; i += (size_t)gridDim.x * blockDim.x) out[i] = __uint_as_float(((unsigned)src[i]) << 16); }
extern "C" void kernel_launch(void* const* d_in, const int* in_sizes, int n_in, void* d_out, int out_size, void* d_ws, size_t ws_size, hipStream_t stream) {
    static int grid = 0;
    if (grid == 0) {
        if (n_in != 31 || in_sizes[0] != T * DM || out_size != T * DM || ws_size < WS_END) {
            fprintf(stderr, "kernel_launch: built for 31 inputs, x/out of %d floats, >= %zu bytes of workspace; got n_in %d, in0 %d, out %d, ws %zu; nothing launched\n", T * DM, (size_t)WS_END, n_in, n_in > 0 ? in_sizes[0] : -1, out_size, ws_size);
            grid = -1; return; }
        int dev = 0, cus = 0, per_cu = 0;
        if (hipGetDevice(&dev) != hipSuccess || hipDeviceGetAttribute(&cus, hipDeviceAttributeMultiprocessorCount, dev) != hipSuccess) { grid = -1; return; }
        if (hipFuncSetAttribute((const void*)fwd_kernel, hipFuncAttributeMaxDynamicSharedMemorySize, LDS_BYTES) != hipSuccess) { fprintf(stderr, "kernel_launch: hipFuncSetAttribute failed\n"); grid = -1; return; }
        if (hipOccupancyMaxActiveBlocksPerMultiprocessor(&per_cu, (const void*)fwd_kernel, 512, LDS_BYTES) != hipSuccess || per_cu < 1)
            fprintf(stderr, "kernel_launch: note: occupancy query reports %d workgroups per CU\n", per_cu);
        (void)hipGetLastError();
        grid = cus;
    }
    if (grid < 0) return;
    if (hipMemsetAsync((char*)d_ws + WS_CTL, 0, CTL_ZERO_BYTES, stream) != hipSuccess) return;
    Args a{};
    for (int i = 0; i < 31; ++i) a.in[i] = d_in[i];
    a.out = (float*)d_out; a.ws = (unsigned char*)d_ws;
#if MK_MULTI
    for (int ph = 0; ph <= DBG_STOP; ++ph) { a.ph_lo = ph; a.ph_hi = ph + 1; hipLaunchKernelGGL(fwd_kernel, dim3(grid), dim3(512), LDS_BYTES, stream, a); }
    if (DBG_DUMP_OFF) hipLaunchKernelGGL(dbg_dump, dim3(2048), dim3(256), 0, stream, (const unsigned short*)((const char*)d_ws + (size_t)DBG_DUMP_OFF), (float*)d_out, (size_t)T * DM);
#else
    a.ph_lo = 0; a.ph_hi = NPHASES;
    hipLaunchKernelGGL(fwd_kernel, dim3(grid), dim3(512), LDS_BYTES, stream, a);
#endif
}
```

```cpp
#include <hip/hip_runtime.h>
#include <cstdio>
#include <cstdint>

#define LAS __attribute__((address_space(3)))
#define GAS __attribute__((address_space(1)))
typedef unsigned short bf16;
typedef short bf16x8 __attribute__((ext_vector_type(8)));
typedef short s16x4 __attribute__((ext_vector_type(4)));
typedef float f32x4 __attribute__((ext_vector_type(4)));
typedef float f32x16 __attribute__((ext_vector_type(16)));
typedef unsigned u32x4 __attribute__((ext_vector_type(4)));
typedef unsigned u32x2 __attribute__((ext_vector_type(2)));

constexpr int NB = 4, SEQ = 8192, T = NB * SEQ, DM = 1024, NLAYER = 2;
constexpr int MLA_H = 8, CQ = 512, CKV = 256, NOPE = 128, ROPE = 64, MLAV = 128, QHD = NOPE + ROPE;
constexpr int DH = 8, DHD = 64;
constexpr int FFD = 2816, NEXP = 8, FFE = 3584;
constexpr int DIN = CQ + CKV + ROPE + 3 * DM;
constexpr float EPS = 1e-6f;
constexpr int NPMAX = T + NEXP * 256;

typedef float f32x2_t __attribute__((ext_vector_type(2))); typedef __bf16 bf16x2_t __attribute__((ext_vector_type(2)));
__device__ __forceinline__ unsigned cvt_pk_bf16(float lo, float hi) { f32x2_t v = {lo, hi}; bf16x2_t b = __builtin_convertvector(v, bf16x2_t); return __builtin_bit_cast(unsigned, b); }
__device__ __forceinline__ float bf_lo(unsigned w) { return __uint_as_float(w << 16); }
__device__ __forceinline__ float bf_hi(unsigned w) { return __uint_as_float(w & 0xffff0000u); }
__device__ __forceinline__ void unpack8(const u32x4 v, float (&f)[8]) { f[0] = bf_lo(v.x); f[1] = bf_hi(v.x); f[2] = bf_lo(v.y); f[3] = bf_hi(v.y); f[4] = bf_lo(v.z); f[5] = bf_hi(v.z); f[6] = bf_lo(v.w); f[7] = bf_hi(v.w); }
__device__ __forceinline__ u32x4 pack8(const float (&f)[8]) { u32x4 v; v.x = cvt_pk_bf16(f[0], f[1]); v.y = cvt_pk_bf16(f[2], f[3]); v.z = cvt_pk_bf16(f[4], f[5]); v.w = cvt_pk_bf16(f[6], f[7]); return v; }
__device__ __forceinline__ float ssq8(const float (&f)[8]) { float s = 0.f;
#pragma unroll
    for (int e = 0; e < 8; ++e) s += f[e] * f[e];
    return s; }
template <int M> __device__ __forceinline__ float xshfl(float v) { return __int_as_float(__builtin_amdgcn_ds_swizzle(__float_as_int(v), 0x1F | (M << 10))); }
__device__ __forceinline__ float wave_sum(float v) {
    v += xshfl<1>(v); v += xshfl<2>(v); v += xshfl<4>(v); v += xshfl<8>(v); v += xshfl<16>(v);
    auto rr = __builtin_amdgcn_permlane32_swap(__float_as_uint(v), __float_as_uint(v), false, false);
    return __uint_as_float(rr[0]) + __uint_as_float(rr[1]);
}
__device__ __forceinline__ int fresh_tid(int wave_s) { unsigned z = 0u; asm volatile("" : "+v"(z)); return wave_s * 64 + (int)__builtin_amdgcn_mbcnt_hi(~0u, __builtin_amdgcn_mbcnt_lo(~0u, z)); }
__device__ __forceinline__ float wave_max(float v) {
    v = fmaxf(v, xshfl<1>(v)); v = fmaxf(v, xshfl<2>(v)); v = fmaxf(v, xshfl<4>(v)); v = fmaxf(v, xshfl<8>(v)); v = fmaxf(v, xshfl<16>(v));
    auto rr = __builtin_amdgcn_permlane32_swap(__float_as_uint(v), __float_as_uint(v), false, false);
    return fmaxf(__uint_as_float(rr[0]), __uint_as_float(rr[1]));
}
__device__ __forceinline__ float sigmoid_f(float x) { return __builtin_amdgcn_rcpf(1.0f + __expf(-x)); }

#ifndef FP8_UPD
#define FP8_UPD 0
#endif
#ifndef FP8_UP
#define FP8_UP 1
#endif
#ifndef FP8_DND
#define FP8_DND 0
#endif
#ifndef FP8_DN
#define FP8_DN 1
#endif
typedef int v8i32 __attribute__((ext_vector_type(8)));
__device__ __forceinline__ float clamp_fp8(float v) { return __builtin_amdgcn_fmed3f(v, -448.0f, 448.0f); }
__device__ __forceinline__ unsigned pk4_fp8(float a, float b, float c, float d) { int w = 0; w = __builtin_amdgcn_cvt_pk_fp8_f32(clamp_fp8(a), clamp_fp8(b), w, false); w = __builtin_amdgcn_cvt_pk_fp8_f32(clamp_fp8(c), clamp_fp8(d), w, true); return (unsigned)w; }
constexpr float MLA_SQS = 0.32267156f;
#define MLA_GG8 1
#define MLA_UPF8 1
#define MLA_G1F8 1
#define MLA_GA8 1
static_assert(!MLA_GG8 || MLA_G1F8, "g_a in fp8 reads the e4m3 copy of h");
constexpr int SC_OA = 0x79797979;
#define MLA_FP8 1
constexpr int SC_ONE = 0x7F7F7F7F, SC_W = 0x7A7A7A7A, SC_ACT = 0x7D7D7D7D;
namespace pg8 {
#define PG8_LAS __attribute__((address_space(3)))
typedef unsigned short bf16_t;
constexpr int BM = 256, BK = 64, HALF = 128, HTB = HALF * BK * 2  , STAGE_BYTES = 8 * HTB, NXCD = 8, WGM = 8;

__host__ __device__ __forceinline__ int lds_byte(int r, int c) { const int st = (r >> 4) * 2 + (c >> 5), rr = r & 15, cc = c & 31, ob = rr * 64 + cc * 2; return st * 1024 + (ob ^ (((ob >> 9) & 1) << 5)); }
__host__ __device__ __forceinline__ void stage_rc(int b, int& R, int& C) { const int st = b / 1024, sb = b % 1024, swz = sb ^ (((sb >> 9) & 1) << 5); R = (st >> 1) * 16 + swz / 64; C = (st & 1) * 32 + (swz % 64) / 2; }
__host__ __device__ __forceinline__ int perm32(int rho) { const int n = rho >> 4, i = rho & 15; return 8 * (i >> 2) + 4 * n + (i & 3); }

struct Unit { int pm, pn; };

struct StaticOrder {
    int nM, nN, nwg, G, c;
    __host__ __device__ void init(int M, int N, int G_, int c_) { nM = M / BM; nN = N / BM; nwg = nM * nN; G = G_; c = c_; }
    __host__ __device__ bool next(int i, Unit& u) const {
        const long L = (long)i * G + c; if (L >= nwg) return false;
        int wgid = (int)L; { const int q = nwg / NXCD, r = nwg % NXCD, xcd = wgid % NXCD, off = wgid / NXCD; wgid = (xcd < r ? xcd * (q + 1) : r * (q + 1) + (xcd - r) * q) + off; }
        const int nig = WGM * nN, gid = wgid / nig, fm = gid * WGM, gsz = (nM - fm) < WGM ? (nM - fm) : WGM;
        u.pm = fm + ((wgid % nig) % gsz); u.pn = (wgid % nig) / gsz; return true;
    }
};

struct ProbPlain {
    static constexpr bool GATHER = false; static constexpr int ESZ = 2;
    const bf16_t* A; int lda; const bf16_t* Bt; int ldb; int K;
    __device__ __forceinline__ const char* a_tile(const Unit& u) const { return (const char*)(A + (size_t)u.pm * BM * lda); }
    __device__ __forceinline__ const char* b_tile(const Unit& u) const { return (const char*)(Bt + (size_t)u.pn * BM * ldb); }
    __device__ __forceinline__ unsigned a_row(const Unit&, int r) const { return (unsigned)r; }
};
struct ProbMoeUp {
    static constexpr bool GATHER = true; static constexpr int ESZ = 2;
    const bf16_t* A; int lda; const bf16_t* Bt; int ldb; int K; size_t estride; const int* tok; const int* tex;
    __device__ __forceinline__ const char* a_tile(const Unit&) const { return (const char*)A; }
    __device__ __forceinline__ const char* b_tile(const Unit& u) const { const int e = __builtin_amdgcn_readfirstlane(tex[u.pm]); return (const char*)(Bt + (size_t)e * estride + (size_t)u.pn * BM * ldb); }
    __device__ __forceinline__ unsigned a_row(const Unit& u, int r) const { const int t = tok[u.pm * BM + r]; return (unsigned)(t < 0 ? 0 : t); }
};
struct ProbMoeDown {
    static constexpr bool GATHER = false; static constexpr int ESZ = 2;
    const bf16_t* A; int lda; const bf16_t* Bt; int ldb; int K; size_t estride; const int* tex;
    __device__ __forceinline__ const char* a_tile(const Unit& u) const { return (const char*)(A + (size_t)u.pm * BM * lda); }
    __device__ __forceinline__ const char* b_tile(const Unit& u) const { const int e = __builtin_amdgcn_readfirstlane(tex[u.pm]); return (const char*)(Bt + (size_t)e * estride + (size_t)u.pn * BM * ldb); }
    __device__ __forceinline__ unsigned a_row(const Unit&, int r) const { return (unsigned)r; }
};

struct ProbPlain8 {
    static constexpr bool GATHER = false; static constexpr int ESZ = 1;
    const unsigned char* A; int lda; const unsigned char* Bt; int ldb; int K; int sa, sb;
    __device__ __forceinline__ const char* a_tile(const Unit& u) const { return (const char*)(A + (size_t)u.pm * BM * lda); }
    __device__ __forceinline__ const char* b_tile(const Unit& u) const { return (const char*)(Bt + (size_t)u.pn * BM * ldb); }
    __device__ __forceinline__ unsigned a_row(const Unit&, int r) const { return (unsigned)r; }
};
struct ProbMoeUp8 {
    static constexpr bool GATHER = true; static constexpr int ESZ = 1;
    const unsigned char* A; int lda; const unsigned char* Bt; int ldb; int K; size_t estride; const int* tok; const int* tex; int sa, sb;
    __device__ __forceinline__ const char* a_tile(const Unit&) const { return (const char*)A; }
    __device__ __forceinline__ const char* b_tile(const Unit& u) const { const int e = __builtin_amdgcn_readfirstlane(tex[u.pm]); return (const char*)(Bt + (size_t)e * estride + (size_t)u.pn * BM * ldb); }
    __device__ __forceinline__ unsigned a_row(const Unit& u, int r) const { const int t = tok[u.pm * BM + r]; return (unsigned)(t < 0 ? 0 : t); }
};
struct ProbMoeDown8 {
    static constexpr bool GATHER = false; static constexpr int ESZ = 1;
    const unsigned char* A; int lda; const unsigned char* Bt; int ldb; int K; size_t estride; const int* tex; int sa, sb;
    __device__ __forceinline__ const char* a_tile(const Unit& u) const { return (const char*)(A + (size_t)u.pm * BM * lda); }
    __device__ __forceinline__ const char* b_tile(const Unit& u) const { const int e = __builtin_amdgcn_readfirstlane(tex[u.pm]); return (const char*)(Bt + (size_t)e * estride + (size_t)u.pn * BM * ldb); }
    __device__ __forceinline__ unsigned a_row(const Unit&, int r) const { return (unsigned)r; }
};
template <class P> __device__ __forceinline__ int prob_sa(const P& p) { if constexpr (P::ESZ == 1) return p.sa; else return 0; }
template <class P> __device__ __forceinline__ int prob_sb(const P& p) { if constexpr (P::ESZ == 1) return p.sb; else return 0; }

struct EpiBf16M {
    static constexpr bool PERM = true;
    bf16_t* O; int ldc; int mode; const bf16_t* aux1; int ld1; const bf16_t* aux2; int ld2;
    __device__ __forceinline__ void operator()(const f32x4 (&acc)[2][2][4][2], const Unit& u, int wr, int wc, int fr, int fq) const {
        const int row0 = u.pm * BM + wr * 64 + fr, col0 = u.pn * BM + wc * 32 + 8 * fq;
#pragma unroll
        for (int ai = 0; ai < 2; ++ai)
#pragma unroll
            for (int m = 0; m < 4; ++m) { const size_t row = (size_t)(row0 + ai * HALF + m * 16);
                float rsc = 1.f; if (mode == 6) { const f32x2_t q = *(const f32x2_t*)((const float*)aux1 + row * 4); rsc = 1.0f / sqrtf((q[0] + q[1]) * (1.f / 512) + EPS); }
#pragma unroll
                for (int bj = 0; bj < 2; ++bj) { const int col = col0 + bj * HALF;
                    float v[8];
#pragma unroll
                    for (int j = 0; j < 4; ++j) { v[j] = acc[ai][bj][m][0][j] * rsc; v[4 + j] = acc[ai][bj][m][1][j] * rsc; }
                    if (mode == 1) {
#pragma unroll
                        for (int j = 0; j < 8; ++j) v[j] = sigmoid_f(v[j]);
                    } else if (mode == 2 || mode == 3) {
                        float g[8]; unpack8(*(const u32x4*)(aux1 + row * ld1 + col), g);
#pragma unroll
                        for (int j = 0; j < 8; ++j) v[j] *= g[j];
                        if (mode == 3) { float a[8]; unpack8(*(const u32x4*)(aux2 + row * ld2 + col), a);
#pragma unroll
                            for (int j = 0; j < 8; ++j) v[j] += a[j]; }
                    }
                    *(u32x4*)(O + row * ldc + col) = pack8(v); }
                asm volatile("" ::: "memory"); }
    }
};
struct EpiBf16G {
    static constexpr bool PERM = true;
    bf16_t* O; int ldc; int gmode; int pn_lo, pn_hi; const float* gain; PG8_LAS float* P;
    float* ssq; int k8; unsigned char* c8;
    __device__ __forceinline__ void operator()(const f32x4 (&acc)[2][2][4][2], const Unit& u, int wr, int wc, int fr, int fq) const {
        const int row0 = u.pm * BM + wr * 64 + fr, col0 = u.pn * BM + wc * 32 + 8 * fq;
        const bool normed = (gmode == 5) || (u.pn >= pn_lo && u.pn < pn_hi);
        const bool stat_only = (gmode == 7);
        if (normed) {
#pragma unroll
            for (int ai = 0; ai < 2; ++ai)
#pragma unroll
                for (int m = 0; m < 4; ++m)
#pragma unroll
                    for (int bj = 0; bj < 2; ++bj) { float s = 0.f;
#pragma unroll
                        for (int n = 0; n < 2; ++n)
#pragma unroll
                            for (int j = 0; j < 4; ++j) s += acc[ai][bj][m][n][j] * acc[ai][bj][m][n][j];
                        s += xshfl<16>(s); { auto rr = __builtin_amdgcn_permlane32_swap(__float_as_uint(s), __float_as_uint(s), false, false); s = __uint_as_float(rr[0]) + __uint_as_float(rr[1]); }
                        if (fq == 0) P[(ai * HALF + wr * 64 + m * 16 + fr) * 8 + bj * 4 + wc] = s; }
            asm volatile("s_waitcnt lgkmcnt(0)\n\ts_barrier" ::: "memory");
        }
        float g0[8];
        { const int gc = (gmode == 5) ? wc * 32 + 8 * fq : (wc & 1) * 32 + 8 * fq;
#pragma unroll
            for (int k = 0; k < 8; ++k) g0[k] = (normed && !stat_only) ? gain[gc + k] : 1.f; }
#pragma unroll
        for (int ai = 0; ai < 2; ++ai)
#pragma unroll
            for (int m = 0; m < 4; ++m) { const size_t row = (size_t)(row0 + ai * HALF + m * 16); const int rl = ai * HALF + wr * 64 + m * 16 + fr;
                float rs[2] = {1.f, 1.f}; bool nb[2] = {false, false};
                if (normed && stat_only) { if (wc == 0 && fq == 0) { const f32x4 a = *(const PG8_LAS f32x4*)(P + rl * 8), b = *(const PG8_LAS f32x4*)(P + rl * 8 + 4); ssq[row * 4 + u.pn] = ((a[0] + a[1]) + (a[2] + a[3])) + ((b[0] + b[1]) + (b[2] + b[3])); } }
                else if (normed) {
                    if (gmode == 5) { const f32x4 a = *(const PG8_LAS f32x4*)(P + rl * 8); float rsc = 1.f, rsc2 = 1.f;
                        if (ssq) { rsc2 = 1.0f / (ssq[row * 4 + 2] * (1.f / 256) + EPS); rsc = sqrtf(rsc2); }
                        rs[0] = rsc / sqrtf(((a[0] + a[1]) + (a[2] + a[3])) * rsc2 * (1.f / 128) + EPS); rs[1] = rsc; nb[0] = true; nb[1] = (ssq != nullptr); }
                    else { const f32x2_t a = *(const PG8_LAS f32x2_t*)(P + rl * 8 + (wc & 2)), b = *(const PG8_LAS f32x2_t*)(P + rl * 8 + 4 + (wc & 2));
                        rs[0] = 1.0f / sqrtf((a[0] + a[1]) * (1.f / 64) + EPS); rs[1] = 1.0f / sqrtf((b[0] + b[1]) * (1.f / 64) + EPS); nb[0] = true; nb[1] = true; } }
#pragma unroll
                for (int bj = 0; bj < 2; ++bj) { const int col = col0 + bj * HALF;
                    float v[8];
#pragma unroll
                    for (int j = 0; j < 4; ++j) { v[j] = acc[ai][bj][m][0][j]; v[4 + j] = acc[ai][bj][m][1][j]; }
                    if (nb[bj]) { const bool ug = !(gmode == 5 && bj == 1);
#pragma unroll
                        for (int k = 0; k < 8; ++k) v[k] *= ug ? rs[bj] * g0[k] : rs[bj]; }
                    if (gmode == 7 && c8) { u32x2 w; w.x = pk4_fp8(v[0], v[1], v[2], v[3]); w.y = pk4_fp8(v[4], v[5], v[6], v[7]); *(u32x2*)(c8 + row * 1024 + col) = w; }
                    if (gmode == 5 && k8 && bj == 0) { u32x2 w; w.x = pk4_fp8(MLA_SQS * v[0], MLA_SQS * v[1], MLA_SQS * v[2], MLA_SQS * v[3]); w.y = pk4_fp8(MLA_SQS * v[4], MLA_SQS * v[5], MLA_SQS * v[6], MLA_SQS * v[7]); *(u32x2*)((unsigned char*)(O + row * ldc + u.pn * BM) + wc * 32 + 8 * fq) = w; }
                    else if (!(gmode == 7 && c8 && u.pn < 3)) *(u32x4*)(O + row * ldc + col) = pack8(v); }
                asm volatile("" ::: "memory"); }
    }
};
struct EpiSwiGLU {
    static constexpr bool PERM = true;
    bf16_t* O; int ldc;
    __device__ __forceinline__ void operator()(const f32x4 (&acc)[2][2][4][2], const Unit& u, int wr, int wc, int fr, int fq) const {
        const int row0 = u.pm * BM + wr * 64 + fr, col0 = u.pn * HALF + wc * 32 + 8 * fq;
#pragma unroll
        for (int ai = 0; ai < 2; ++ai)
#pragma unroll
            for (int m = 0; m < 4; ++m) { const size_t row = (size_t)(row0 + ai * HALF + m * 16);
                float v[8];
#pragma unroll
                for (int j = 0; j < 4; ++j) { const float g0 = acc[ai][0][m][0][j], g1 = acc[ai][0][m][1][j];
                    v[j] = g0 * sigmoid_f(g0) * acc[ai][1][m][0][j]; v[4 + j] = g1 * sigmoid_f(g1) * acc[ai][1][m][1][j]; }
                *(u32x4*)(O + row * ldc + col0) = pack8(v);
                asm volatile("" ::: "memory"); }
    }
};
struct EpiSwiGLU8 {
    static constexpr bool PERM = true;
    unsigned char* O; int ldc;
    __device__ __forceinline__ void operator()(const f32x4 (&acc)[2][2][4][2], const Unit& u, int wr, int wc, int fr, int fq) const {
        const int row0 = u.pm * BM + wr * 64 + fr, col0 = u.pn * HALF + wc * 32 + 8 * fq;
#pragma unroll
        for (int ai = 0; ai < 2; ++ai)
#pragma unroll
            for (int m = 0; m < 4; ++m) { const size_t row = (size_t)(row0 + ai * HALF + m * 16);
                float v[8];
#pragma unroll
                for (int j = 0; j < 4; ++j) { const float g0 = acc[ai][0][m][0][j], g1 = acc[ai][0][m][1][j];
                    v[j] = 4.0f * g0 * sigmoid_f(g0) * acc[ai][1][m][0][j]; v[4 + j] = 4.0f * g1 * sigmoid_f(g1) * acc[ai][1][m][1][j]; }
                u32x2 w; w.x = pk4_fp8(v[0], v[1], v[2], v[3]); w.y = pk4_fp8(v[4], v[5], v[6], v[7]);
                *(u32x2*)(O + row * ldc + col0) = w;
                asm volatile("" ::: "memory"); }
    }
};
struct EpiF32Res {
    static constexpr bool PERM = false;
    const float* base; float* out; int ldc;
    __device__ __forceinline__ void operator()(const f32x4 (&acc)[2][2][4][2], const Unit& u, int wr, int wc, int fr, int fq) const {
        const int row0 = u.pm * BM + wr * 64 + fr, col0 = u.pn * BM + wc * 32 + 4 * fq;
#pragma unroll
        for (int ai = 0; ai < 2; ++ai)
#pragma unroll
            for (int m = 0; m < 4; ++m) { const size_t off = (size_t)(row0 + ai * HALF + m * 16) * ldc + col0;
#pragma unroll
                for (int bj = 0; bj < 2; ++bj)
#pragma unroll
                    for (int n = 0; n < 2; ++n) { const f32x4 b = *(const f32x4*)(base + off + bj * HALF + n * 16); *(f32x4*)(out + off + bj * HALF + n * 16) = b + acc[ai][bj][m][n]; }
                asm volatile("" ::: "memory"); }
    }
};
struct EpiMoeDown {
    static constexpr bool PERM = false;
    float* out; int ldc; const int* tok; const float* wt;
    __device__ __forceinline__ void operator()(const f32x4 (&acc)[2][2][4][2], const Unit& u, int wr, int wc, int fr, int fq) const {
        const int row0 = u.pm * BM + wr * 64 + fr, col0 = u.pn * BM + wc * 32 + 4 * fq;
#pragma unroll
        for (int ai = 0; ai < 2; ++ai)
#pragma unroll
            for (int m = 0; m < 4; ++m) { const int r = row0 + ai * HALF + m * 16; const int t = tok[r]; const float w = wt[r];
                if (t >= 0) { float* rowp = out + (size_t)t * ldc + col0;
#pragma unroll
                    for (int bj = 0; bj < 2; ++bj)
#pragma unroll
                        for (int n = 0; n < 2; ++n) { const f32x4 b = *(const f32x4*)(rowp + bj * HALF + n * 16); *(f32x4*)(rowp + bj * HALF + n * 16) = b + w * acc[ai][bj][m][n]; } }
                asm volatile("" ::: "memory"); }
    }
};

template <class Prob, class Epi, class Sched>
__device__ __forceinline__ void gemm_phase(PG8_LAS unsigned char* lds, const Prob& P, const Sched& S, const Epi& E, const int tid_in) {
    int tid_ = tid_in; asm volatile("" : "+v"(tid_));
    const int tid = tid_, wid = __builtin_amdgcn_readfirstlane(tid >> 6), lane = tid & 63, wr = wid >> 2, wc = wid & 3, fr = lane & 15, fq = lane >> 4;
    constexpr int ESZ = Prob::ESZ;
    const int K = P.K, nt = K / (128 / ESZ); const int sca = prob_sa(P), scb = prob_sb(P); (void)sca; (void)scb;
    int sR[2], sC[2]; unsigned voffA[2], voffB[2];
#pragma unroll
    for (int i = 0; i < 2; ++i) { int R, C; stage_rc(tid * 16 + i * 8192, R, C); sR[i] = R; sC[i] = C; const int Rb = Epi::PERM ? ((R & ~31) + perm32(R & 31)) : R;
        voffA[i] = (unsigned)(R * P.lda) * (unsigned)ESZ + (unsigned)C * 2u; voffB[i] = (unsigned)(Rb * P.ldb) * (unsigned)ESZ + (unsigned)C * 2u; }
    const size_t kstep = (size_t)(BK * 2);
    const size_t hstepA = (size_t)HALF * P.lda * ESZ, hstepB = (size_t)HALF * P.ldb * ESZ;
    const unsigned ldsw = (unsigned)wid * 1024u;
    const int aoff = lds_byte(wr * 64 + fr, fq * 8), boff = lds_byte(wc * 32 + fr, fq * 8);
#define PG8_SA(b, h) (((b) * 2 + (h)) * HTB)
#define PG8_SB(b, h) ((4 + (b) * 2 + (h)) * HTB)
#define PG8_STAGE2(bufoff, gbase, v0, v1) do { \
        __builtin_amdgcn_global_load_lds((const unsigned*)((const char*)(gbase) + (v0)), (PG8_LAS unsigned*)(lds + (bufoff) + ldsw), 16, 0, 0); \
        __builtin_amdgcn_global_load_lds((const unsigned*)((const char*)(gbase) + (v1)), (PG8_LAS unsigned*)(lds + (bufoff) + ldsw + 8192), 16, 0, 0); } while (0)
#define PG8_STAGEB(bufoff, gbase) PG8_STAGE2(bufoff, gbase, voffB[0], voffB[1])
#define PG8_AOFF(h, i, nx) (Prob::GATHER ? ((nx) ? nvo[h][i] : cvo[h][i]) : voffA[i])
#define PG8_STAGEA(bufoff, gbase, h, nx) PG8_STAGE2(bufoff, (Prob::GATHER ? (gbase) : (gbase) + (h) * hstepA), PG8_AOFF(h, 0, nx), PG8_AOFF(h, 1, nx))
#define PG8_LDA(dst, b, h) do { if constexpr (ESZ == 2) { _Pragma("unroll") for (int m = 0; m < 4; ++m) _Pragma("unroll") for (int k = 0; k < 2; ++k) dst[m][k] = *(const PG8_LAS bf16x8*)(lds + PG8_SA(b, h) + aoff + m * 2048 + k * 1024); } \
    else { _Pragma("unroll") for (int m = 0; m < 4; ++m) dst##8[m] = __builtin_shufflevector(*(const PG8_LAS u32x4*)(lds + PG8_SA(b, h) + aoff + m * 2048), *(const PG8_LAS u32x4*)(lds + PG8_SA(b, h) + aoff + m * 2048 + 1024), 0, 1, 2, 3, 4, 5, 6, 7); } } while (0)
#define PG8_LDB(dst, b, h) do { if constexpr (ESZ == 2) { _Pragma("unroll") for (int n = 0; n < 2; ++n) _Pragma("unroll") for (int k = 0; k < 2; ++k) dst[n][k] = *(const PG8_LAS bf16x8*)(lds + PG8_SB(b, h) + boff + n * 2048 + k * 1024); } \
    else { _Pragma("unroll") for (int n = 0; n < 2; ++n) dst##8[n] = __builtin_shufflevector(*(const PG8_LAS u32x4*)(lds + PG8_SB(b, h) + boff + n * 2048), *(const PG8_LAS u32x4*)(lds + PG8_SB(b, h) + boff + n * 2048 + 1024), 0, 1, 2, 3, 4, 5, 6, 7); } } while (0)
#define PG8_MMA(ai, bj, At, Bt) do { __builtin_amdgcn_s_setprio(1); \
        if constexpr (ESZ == 2) { _Pragma("unroll") for (int m = 0; m < 4; ++m) _Pragma("unroll") for (int n = 0; n < 2; ++n) _Pragma("unroll") for (int k = 0; k < 2; ++k) \
            acc[ai][bj][m][n] = __builtin_amdgcn_mfma_f32_16x16x32_bf16(Bt[n][k], At[m][k], acc[ai][bj][m][n], 0, 0, 0); } \
        else { _Pragma("unroll") for (int m = 0; m < 4; ++m) _Pragma("unroll") for (int n = 0; n < 2; ++n) \
            asm volatile("v_mfma_scale_f32_16x16x128_f8f6f4 %0, %1, %2, %0, %3, %4 op_sel_hi:[0,0,0]" : "+v"(acc[ai][bj][m][n]) : "v"(Bt##8[n]), "v"(At##8[m]), "v"(scb), "v"(sca)); } \
        __builtin_amdgcn_s_setprio(0); } while (0)
#define PG8_WAIT_V(n) asm volatile("s_waitcnt vmcnt(" #n ")" ::: "memory")
#define PG8_WAIT_L(n) asm volatile("s_waitcnt lgkmcnt(" #n ")" ::: "memory")
#define PG8_BAR __builtin_amdgcn_s_barrier()
#define PG8_SCHED __builtin_amdgcn_sched_barrier(0)
#define PG8_ROWS(dst, u) do { _Pragma("unroll") for (int h = 0; h < 2; ++h) _Pragma("unroll") for (int i = 0; i < 2; ++i) \
        dst[h][i] = P.a_row(u, h * HALF + sR[i]) * (unsigned)P.lda * (unsigned)ESZ + (unsigned)sC[i] * 2u; } while (0)
    Unit cur, nxt; int ui = 0;
    if (!S.next(0, cur)) return;
    f32x4 acc[2][2][4][2];
#pragma unroll
    for (int a = 0; a < 2; ++a)
#pragma unroll
        for (int b = 0; b < 2; ++b)
#pragma unroll
            for (int m = 0; m < 4; ++m)
#pragma unroll
                for (int n = 0; n < 2; ++n) acc[a][b][m][n] = (f32x4){0.f, 0.f, 0.f, 0.f};
    bf16x8 At[4][2], B0[2][2], B1[2][2]; typedef unsigned u32x8 __attribute__((ext_vector_type(8))); u32x8 At8[4], B08[2], B18[2];
    unsigned cvo[2][2], nvo[2][2];
    if constexpr (Prob::GATHER) { PG8_ROWS(cvo, cur);
#pragma unroll
        for (int h = 0; h < 2; ++h)
#pragma unroll
            for (int i = 0; i < 2; ++i) nvo[h][i] = cvo[h][i]; }
    const char* cA = P.a_tile(cur); const char* cB = P.b_tile(cur);
    PG8_STAGEB(PG8_SB(0, 0), cB); PG8_STAGEB(PG8_SB(0, 1), cB + hstepB); PG8_STAGEA(PG8_SA(0, 0), cA, 0, false); PG8_STAGEA(PG8_SA(0, 1), cA, 1, false);
    if (wr == 1) PG8_BAR;
    PG8_WAIT_V(2); PG8_BAR;
    PG8_STAGEB(PG8_SB(1, 0), cB + kstep); PG8_STAGEA(PG8_SA(1, 0), cA + kstep, 0, false); PG8_STAGEB(PG8_SB(1, 1), cB + hstepB + kstep);
    PG8_WAIT_V(6); PG8_BAR;
    for (;;) {
        const bool has_next = S.next(ui + 1, nxt);
        const char* nA = has_next ? P.a_tile(nxt) : cA; const char* nB = has_next ? P.b_tile(nxt) : cB;
        if constexpr (Prob::GATHER) { if (has_next) PG8_ROWS(nvo, nxt); }
        for (int t = 0; t < nt; t += 2) {
            const bool last = (t == nt - 2);
            const char* a1 = cA + (size_t)(t + 1) * kstep;
            const char* a2 = last ? nA : cA + (size_t)(t + 2) * kstep; const char* b2 = last ? nB : cB + (size_t)(t + 2) * kstep;
            const char* a3 = a2 + kstep; const char* b3 = b2 + kstep;
            const bool nx = Prob::GATHER ? last : false;
            PG8_LDB(B0, 0, 0); PG8_LDB(B1, 0, 1); PG8_SCHED; PG8_LDA(At, 0, 0); PG8_STAGEA(PG8_SA(1, 1), a1, 1, false);
            PG8_WAIT_V(8); PG8_WAIT_L(0); PG8_BAR; PG8_MMA(0, 0, At, B0); PG8_MMA(0, 1, At, B1); PG8_BAR; PG8_SCHED;
            PG8_LDA(At, 0, 1); PG8_STAGEB(PG8_SB(0, 0), b2); PG8_STAGEB(PG8_SB(0, 1), b2 + hstepB); PG8_STAGEA(PG8_SA(0, 0), a2, 0, nx);
            PG8_WAIT_V(8); PG8_WAIT_L(0); PG8_BAR; PG8_MMA(1, 0, At, B0); PG8_MMA(1, 1, At, B1); PG8_BAR; PG8_SCHED;
            PG8_LDB(B0, 1, 0); PG8_LDB(B1, 1, 1); PG8_SCHED; PG8_LDA(At, 1, 0); PG8_STAGEA(PG8_SA(0, 1), a2, 1, nx);
            PG8_WAIT_V(8); PG8_WAIT_L(0); PG8_BAR; PG8_MMA(0, 0, At, B0); PG8_MMA(0, 1, At, B1); PG8_BAR; PG8_SCHED;
            PG8_LDA(At, 1, 1); PG8_STAGEB(PG8_SB(1, 0), b3); PG8_STAGEB(PG8_SB(1, 1), b3 + hstepB); PG8_STAGEA(PG8_SA(1, 0), a3, 0, nx);
            PG8_WAIT_V(8); PG8_WAIT_L(0); PG8_BAR; PG8_MMA(1, 0, At, B0); PG8_MMA(1, 1, At, B1); PG8_BAR; PG8_SCHED;
        }
        if (wr == 0) PG8_BAR;
        if constexpr (ESZ == 1) asm volatile("s_nop 15\n\ts_nop 15\n\ts_nop 15" ::: "memory");
        E(acc, cur, wr, wc, fr, fq);
        if (!has_next) break;
#pragma unroll
        for (int a = 0; a < 2; ++a)
#pragma unroll
            for (int b = 0; b < 2; ++b)
#pragma unroll
                for (int m = 0; m < 4; ++m)
#pragma unroll
                    for (int n = 0; n < 2; ++n) acc[a][b][m][n] = (f32x4){0.f, 0.f, 0.f, 0.f};
        cur = nxt; cA = nA; cB = nB; ++ui;
        if constexpr (Prob::GATHER) {
#pragma unroll
            for (int h = 0; h < 2; ++h)
#pragma unroll
                for (int i = 0; i < 2; ++i) cvo[h][i] = nvo[h][i]; }
        if (wr == 1) PG8_BAR;
    }
    PG8_WAIT_V(0);
    PG8_BAR;
#undef PG8_SA
#undef PG8_SB
#undef PG8_STAGE2
#undef PG8_STAGEB
#undef PG8_STAGEA
#undef PG8_AOFF
#undef PG8_LDA
#undef PG8_LDB
#undef PG8_MMA
#undef PG8_WAIT_V
#undef PG8_WAIT_L
#undef PG8_BAR
#undef PG8_SCHED
#undef PG8_ROWS
}
}

namespace att {
constexpr int NW = 8, QBLK = 32, KVBLK = 64, DV = 128;
constexpr int SHM_V = KVBLK * DV * 2;
constexpr int OFF_V = 0, OFF_K = 2 * SHM_V;
constexpr int KB_MAX = KVBLK * 192 * 2;
constexpr int OFF_WS = OFF_K + 2 * KB_MAX, OFF_POS = OFF_WS + NW * 64 * 4, OFF_QR = OFF_POS + 2 * 64 * 4, LDS_BYTES = OFF_QR + NW * 4096;
constexpr float THR = 8.f;
typedef LAS char* lptr;
#define SBAR() __builtin_amdgcn_sched_barrier(0)
__device__ __forceinline__ int crow(int r, int hi) { return (r & 3) + 8 * (r >> 2) + 4 * hi; }
template <int DQK> __device__ __forceinline__ int kswz(int row, int c) { return row * (DQK * 2) + (((c & ~7) | ((c ^ (row >> 1)) & 7)) << 4); }
__device__ __forceinline__ int v_st(int k, int c) { const int kk = (k & ~0xC) | ((k & 4) << 1) | ((k & 8) >> 1); return ((kk >> 3) * 4 + (c >> 5)) * 512 + ((kk & 7) * 32 + (c & 31)) * 2; }
__device__ __forceinline__ int v_rd_base(int lane) { return ((lane & 3) << 3) | (((lane >> 2) & 3) << 6) | (((lane >> 4) & 1) << 5) | (((lane >> 5) & 1) << 8); }
constexpr int v_rd_off(int d0, int ks, int half) { return d0 * 512 + ks * 4096 + half * 2048; }
template <int OFF> __device__ __forceinline__ s16x4 tr_read(int vb) { s16x4 r; asm volatile("ds_read_b64_tr_b16 %0, %1 offset:%2" : "=&v"(r) : "v"(vb), "i"(OFF) : "memory"); return r; }

template <int D0> __device__ __forceinline__ void pv_one(f32x16& od, int vb, bf16x8 pa0, bf16x8 pa1, bf16x8 pa2, bf16x8 pa3) {
  const s16x4 l0 = tr_read<v_rd_off(D0, 0, 0)>(vb), h0 = tr_read<v_rd_off(D0, 0, 1)>(vb), l1 = tr_read<v_rd_off(D0, 1, 0)>(vb), h1 = tr_read<v_rd_off(D0, 1, 1)>(vb);
  const s16x4 l2 = tr_read<v_rd_off(D0, 2, 0)>(vb), h2 = tr_read<v_rd_off(D0, 2, 1)>(vb), l3 = tr_read<v_rd_off(D0, 3, 0)>(vb), h3 = tr_read<v_rd_off(D0, 3, 1)>(vb);
  asm volatile("s_waitcnt lgkmcnt(0)" ::: "memory"); SBAR();
#define PK(L, H) (bf16x8){L[0], L[1], L[2], L[3], H[0], H[1], H[2], H[3]}
  od = __builtin_amdgcn_mfma_f32_32x32x16_bf16(pa0, PK(l0, h0), od, 0, 0, 0);
  od = __builtin_amdgcn_mfma_f32_32x32x16_bf16(pa1, PK(l1, h1), od, 0, 0, 0);
  od = __builtin_amdgcn_mfma_f32_32x32x16_bf16(pa2, PK(l2, h2), od, 0, 0, 0);
  od = __builtin_amdgcn_mfma_f32_32x32x16_bf16(pa3, PK(l3, h3), od, 0, 0, 0);
#undef PK
}
__device__ __forceinline__ void pv_d0(f32x16* o, int vb, bf16x8 pa0, bf16x8 pa1, bf16x8 pa2, bf16x8 pa3) {
  pv_one<0>(o[0], vb, pa0, pa1, pa2, pa3); pv_one<1>(o[1], vb, pa0, pa1, pa2, pa3); pv_one<2>(o[2], vb, pa0, pa1, pa2, pa3); pv_one<3>(o[3], vb, pa0, pa1, pa2, pa3);
}

constexpr int D_OFF_V = 0, D_OFF_KN = 32768, D_OFF_KR = 65536, D_OFF_WS = 81920, D_OFF_POS = 83968, D_OFF_QX = 88064, D_OFF_TT = D_OFF_QX + 8 * 4096, D_LDS_BYTES = D_OFF_TT + 1024;
__device__ __forceinline__ const char* sgpr_ptr(const char* p) { const unsigned lo = __builtin_amdgcn_readfirstlane((unsigned)(uintptr_t)p), hi = __builtin_amdgcn_readfirstlane((unsigned)((uintptr_t)p >> 32)); return (const char*)(((uintptr_t)hi << 32) | lo); }
__device__ __forceinline__ void glds16(const char* g, unsigned voff, lptr l) { __builtin_amdgcn_global_load_lds((const unsigned*)(g + voff), (LAS unsigned*)l, 16, 0, 0); }
__device__ __forceinline__ void glds16s(const char* g, unsigned voff, lptr l) { const unsigned m = __builtin_amdgcn_readfirstlane((unsigned)(uintptr_t)l); const char* gs = sgpr_ptr(g);
  asm volatile("s_mov_b32 m0, %0\n\tglobal_load_lds_dwordx4 %1, %2" :: "s"(m), "v"(voff), "s"(gs) : "memory", "m0"); }
__device__ __forceinline__ void glds4s(const char* g, unsigned voff, lptr l) { const unsigned m = __builtin_amdgcn_readfirstlane((unsigned)(uintptr_t)l); const char* gs = sgpr_ptr(g);
  asm volatile("s_mov_b32 m0, %0\n\tglobal_load_lds_dword %1, %2" :: "s"(m), "v"(voff), "s"(gs) : "memory", "m0"); }
__device__ __forceinline__ void glds4(const char* g, unsigned voff, lptr l) { __builtin_amdgcn_global_load_lds((const unsigned*)(g + voff), (LAS unsigned*)l, 4, 0, 0); }
__device__ __forceinline__ void kpre64(bf16x8 (&kf)[8], f32x4 (&pkv)[8], const lptr Kr, const LAS float* pk, const bool alibi, int r32, int hi) {
  const lptr rr = Kr + r32 * 128; const int k8 = (r32 >> 1) & 7;
#pragma unroll
  for (int d0 = 0; d0 < 4; ++d0) { const int cs = (((2 * d0 + hi) ^ k8) & 7) << 4; kf[2 * d0] = *(const LAS bf16x8*)(rr + cs); kf[2 * d0 + 1] = *(const LAS bf16x8*)(rr + 4096 + cs); }
  if (alibi) {
#pragma unroll
    for (int g = 0; g < 4; ++g) { pkv[g] = *(const LAS f32x4*)(pk + 8 * g + 4 * hi); pkv[4 + g] = *(const LAS f32x4*)(pk + 32 + 8 * g + 4 * hi); } }
}
__device__ __forceinline__ void qkt64(f32x16& p0, f32x16& p1, const bf16x8 (&kf)[8], const bf16x8* qr, const f32x16& negm, const bool fold, const bf16x8 kext0, const bf16x8 kext1, const bf16x8 qext) {
  p0 = __builtin_amdgcn_mfma_f32_32x32x16_bf16(kf[0], qr[0], negm, 0, 0, 0); p1 = __builtin_amdgcn_mfma_f32_32x32x16_bf16(kf[1], qr[0], negm, 0, 0, 0);
#pragma unroll
  for (int d0 = 1; d0 < 4; ++d0) { p0 = __builtin_amdgcn_mfma_f32_32x32x16_bf16(kf[2 * d0], qr[d0], p0, 0, 0, 0); p1 = __builtin_amdgcn_mfma_f32_32x32x16_bf16(kf[2 * d0 + 1], qr[d0], p1, 0, 0, 0); }
  if (fold) { p0 = __builtin_amdgcn_mfma_f32_32x32x16_bf16(kext0, qext, p0, 0, 0, 0); p1 = __builtin_amdgcn_mfma_f32_32x32x16_bf16(kext1, qext, p1, 0, 0, 0); }
}
template <int DQK>
__device__ __forceinline__ void qkt_d(f32x16& p0, f32x16& p1, const lptr Kn, const lptr Kr, const bf16x8* qr, const lptr qx, const f32x16& negm, int r32, int hi) {
  const lptr rn = Kn + r32 * 256, rr = Kr + r32 * 128; const int k16 = r32 & 15, k8 = (r32 >> 1) & 7;
#pragma unroll
  for (int d0 = 0; d0 < DQK / 16; ++d0) {
    bf16x8 b0, b1;
    if (DQK == 192 && d0 < 8) { const int cs = ((2 * d0 + hi) ^ k16) << 4; b0 = *(const LAS bf16x8*)(rn + cs); b1 = *(const LAS bf16x8*)(rn + 8192 + cs); }
    else { const int cr = (DQK == 192) ? 2 * (d0 - 8) + hi : 2 * d0 + hi; const int cs = ((cr ^ k8) & 7) << 4; b0 = *(const LAS bf16x8*)(rr + cs); b1 = *(const LAS bf16x8*)(rr + 4096 + cs); }
    bf16x8 q;
    if (d0 < 8) q = qr[d0 < 8 ? d0 : 0]; else q = *(const LAS bf16x8*)(qx + r32 * 128 + ((((2 * (d0 - 8) + hi) ^ k8) & 7) << 4));
    if (d0 == 0) { p0 = __builtin_amdgcn_mfma_f32_32x32x16_bf16(b0, q, negm, 0, 0, 0); p1 = __builtin_amdgcn_mfma_f32_32x32x16_bf16(b1, q, negm, 0, 0, 0); }
    else { p0 = __builtin_amdgcn_mfma_f32_32x32x16_bf16(b0, q, p0, 0, 0, 0); p1 = __builtin_amdgcn_mfma_f32_32x32x16_bf16(b1, q, p1, 0, 0, 0); } }
}
#define MX3(a, b, c) __builtin_fmaxf(__builtin_fmaxf((a), (b)), (c))
template <bool ALIBI, bool FIRST>
__device__ __forceinline__ void softmax_a(f32x16& p0, f32x16& p1, float& mhat, f32x16& negm, float& l_reg, float& alpha, const f32x4 (&pkv)[8], const float pq, const float nsl2) {
  constexpr float THRL = 11.0f;
  if constexpr (ALIBI) {
#pragma unroll
    for (int g = 0; g < 4; ++g) { const f32x4 a = pkv[g], b = pkv[4 + g];
#pragma unroll
      for (int j = 0; j < 4; ++j) { p0[4 * g + j] = fmaf(fabsf(a[j] - pq), nsl2, p0[4 * g + j]); p1[4 * g + j] = fmaf(fabsf(b[j] - pq), nsl2, p1[4 * g + j]); } }
  }
  float a = MX3(p0[0], p0[1], p1[0]), b = MX3(p0[2], p0[3], p1[1]); a = MX3(a, p1[2], p1[3]);
#pragma unroll
  for (int r = 4; r < 16; r += 4) { a = MX3(a, p0[r], p0[r + 1]); b = MX3(b, p0[r + 2], p0[r + 3]); a = MX3(a, p1[r], p1[r + 1]); b = MX3(b, p1[r + 2], p1[r + 3]); }
  float rm = fmaxf(a, b);
  { auto rr = __builtin_amdgcn_permlane32_swap(__float_as_uint(rm), __float_as_uint(rm), false, false); rm = fmaxf(__uint_as_float(rr[0]), __uint_as_float(rr[1])); }
  alpha = 1.f;
  if (FIRST || __builtin_expect(__any(rm > THRL), 0)) { const float dl = FIRST ? rm : fmaxf(rm, 0.f); mhat += dl;
#pragma unroll
    for (int r = 0; r < 16; ++r) { p0[r] -= dl; p1[r] -= dl; }
#pragma unroll
    for (int r = 0; r < 16; ++r) negm[r] = -mhat;
    asm volatile("" : "+v"(negm));
    if (!FIRST) { alpha = __builtin_amdgcn_exp2f(-dl); l_reg *= alpha; } }
#pragma unroll
  for (int r = 0; r < 16; ++r) p0[r] = __builtin_amdgcn_exp2f(p0[r]);
}
__device__ __forceinline__ void softmax_b(f32x16& p0, f32x16& p1, float& l_reg, bf16x8& pa0, bf16x8& pa1, bf16x8& pa2, bf16x8& pa3) {
#pragma unroll
  for (int r = 0; r < 16; ++r) p1[r] = __builtin_amdgcn_exp2f(p1[r]);
  float ps = 0;
#pragma unroll
  for (int r = 0; r < 16; ++r) ps += p0[r];
#pragma unroll
  for (int r = 0; r < 16; ++r) ps += p1[r];
  { auto rr = __builtin_amdgcn_permlane32_swap(__float_as_uint(ps), __float_as_uint(ps), false, false); ps = __uint_as_float(rr[0]) + __uint_as_float(rr[1]); }
  l_reg += ps;
#define PK4(P, BASE, OUT) do { unsigned a0 = cvt_pk_bf16(P[BASE + 0], P[BASE + 1]), a1 = cvt_pk_bf16(P[BASE + 2], P[BASE + 3]);   \
    unsigned b0 = cvt_pk_bf16(P[BASE + 4], P[BASE + 5]), b1 = cvt_pk_bf16(P[BASE + 6], P[BASE + 7]);                              \
    auto r0 = __builtin_amdgcn_permlane32_swap(a0, b0, false, false); auto r1 = __builtin_amdgcn_permlane32_swap(a1, b1, false, false); \
    u32x4 w = {r0[0], r1[0], r0[1], r1[1]}; OUT = __builtin_bit_cast(bf16x8, w); } while (0)
  PK4(p0, 0, pa0); PK4(p0, 8, pa1); PK4(p1, 0, pa2); PK4(p1, 8, pa3);
#undef PK4
}
template <bool ALIBI, bool NOMAX = false>
__device__ __forceinline__ void sm_chunk(f32x16& p0, f32x16& p1, float& mx, const int g, const LAS float* pk, const int hi, const float pq, const float nsl2, const bool fold) {
  if (ALIBI && !fold) { const f32x4 a = *(const LAS f32x4*)(pk + 8 * g + 4 * hi), b = *(const LAS f32x4*)(pk + 32 + 8 * g + 4 * hi);
#pragma unroll
    for (int j = 0; j < 4; ++j) { p0[4 * g + j] = fmaf(fabsf(a[j] - pq), nsl2, p0[4 * g + j]); p1[4 * g + j] = fmaf(fabsf(b[j] - pq), nsl2, p1[4 * g + j]); } }
  if constexpr (!NOMAX) { mx = MX3(mx, p0[4 * g], p0[4 * g + 1]); mx = MX3(mx, p0[4 * g + 2], p0[4 * g + 3]); mx = MX3(mx, p1[4 * g], p1[4 * g + 1]); mx = MX3(mx, p1[4 * g + 2], p1[4 * g + 3]); }
}
template <bool FIRST>
__device__ __forceinline__ void sm_tail(f32x16& p0, f32x16& p1, float rm, float& mhat, f32x16& negm, float& l_reg, float& alpha) {
  constexpr float THRL = 11.0f;
  { auto rr = __builtin_amdgcn_permlane32_swap(__float_as_uint(rm), __float_as_uint(rm), false, false); rm = fmaxf(__uint_as_float(rr[0]), __uint_as_float(rr[1])); }
  alpha = 1.f;
  if (FIRST || __builtin_expect(__any(rm > THRL), 0)) { const float dl = FIRST ? rm : fmaxf(rm, 0.f); mhat += dl;
#pragma unroll
    for (int r = 0; r < 16; ++r) { p0[r] -= dl; p1[r] -= dl; }
#pragma unroll
    for (int r = 0; r < 16; ++r) negm[r] = -mhat;
    asm volatile("" : "+v"(negm));
    if (!FIRST) { alpha = __builtin_amdgcn_exp2f(-dl); l_reg *= alpha; } }
#pragma unroll
  for (int r = 0; r < 16; ++r) p0[r] = __builtin_amdgcn_exp2f(p0[r]);
}
__device__ __forceinline__ void sm_exp1(f32x16& p1) {
#pragma unroll
  for (int r = 0; r < 16; ++r) p1[r] = __builtin_amdgcn_exp2f(p1[r]);
}
__device__ __forceinline__ void sm_sumpack(f32x16& p0, f32x16& p1, float& l_reg, bf16x8& pa0, bf16x8& pa1, bf16x8& pa2, bf16x8& pa3) {
  float ps = 0;
#pragma unroll
  for (int r = 0; r < 16; ++r) ps += p0[r];
#pragma unroll
  for (int r = 0; r < 16; ++r) ps += p1[r];
  { auto rr = __builtin_amdgcn_permlane32_swap(__float_as_uint(ps), __float_as_uint(ps), false, false); ps = __uint_as_float(rr[0]) + __uint_as_float(rr[1]); }
  l_reg += ps;
#define PK4(P, BASE, OUT) do { unsigned a0 = cvt_pk_bf16(P[BASE + 0], P[BASE + 1]), a1 = cvt_pk_bf16(P[BASE + 2], P[BASE + 3]);   \
    unsigned b0 = cvt_pk_bf16(P[BASE + 4], P[BASE + 5]), b1 = cvt_pk_bf16(P[BASE + 6], P[BASE + 7]);                              \
    auto r0 = __builtin_amdgcn_permlane32_swap(a0, b0, false, false); auto r1 = __builtin_amdgcn_permlane32_swap(a1, b1, false, false); \
    u32x4 w = {r0[0], r1[0], r0[1], r1[1]}; OUT = __builtin_bit_cast(bf16x8, w); } while (0)
  PK4(p0, 0, pa0); PK4(p0, 8, pa1); PK4(p1, 0, pa2); PK4(p1, 8, pa3);
#undef PK4
}
template <bool ALIBI, int D0, bool NOMAX = false>
__device__ __forceinline__ void pv_sm_one(f32x16& od, int vb, bf16x8 pa0, bf16x8 pa1, bf16x8 pa2, bf16x8 pa3, f32x16& x0, f32x16& x1, float& mx, const LAS float* pk, const int hi, const float pq, const float nsl2, const bool fold) {
  const s16x4 l0 = tr_read<v_rd_off(D0, 0, 0)>(vb), h0 = tr_read<v_rd_off(D0, 0, 1)>(vb), l1 = tr_read<v_rd_off(D0, 1, 0)>(vb), h1 = tr_read<v_rd_off(D0, 1, 1)>(vb);
  const s16x4 l2 = tr_read<v_rd_off(D0, 2, 0)>(vb), h2 = tr_read<v_rd_off(D0, 2, 1)>(vb), l3 = tr_read<v_rd_off(D0, 3, 0)>(vb), h3 = tr_read<v_rd_off(D0, 3, 1)>(vb);
  SBAR(); sm_chunk<ALIBI, NOMAX>(x0, x1, mx, D0, pk, hi, pq, nsl2, fold); SBAR();
  asm volatile("s_waitcnt lgkmcnt(0)" ::: "memory"); SBAR();
#define PK(L, H) (bf16x8){L[0], L[1], L[2], L[3], H[0], H[1], H[2], H[3]}
  od = __builtin_amdgcn_mfma_f32_32x32x16_bf16(pa0, PK(l0, h0), od, 0, 0, 0);
  od = __builtin_amdgcn_mfma_f32_32x32x16_bf16(pa1, PK(l1, h1), od, 0, 0, 0);
  od = __builtin_amdgcn_mfma_f32_32x32x16_bf16(pa2, PK(l2, h2), od, 0, 0, 0);
  od = __builtin_amdgcn_mfma_f32_32x32x16_bf16(pa3, PK(l3, h3), od, 0, 0, 0);
#undef PK
}
template <int DQK, bool ALIBI, int EPI = 0, bool FIXREF = false>
__device__ __forceinline__ void attn_unit_dma(const bf16* __restrict__ Qb, int ldq, const bf16* __restrict__ Kh, int ldk, const bf16* __restrict__ KRh, const bf16* __restrict__ Vh, int ldv,
                                              bf16* __restrict__ Ob, int ldo, const float* __restrict__ posq, const float* __restrict__ posk, const float nsl, const float scale, const int seq, const lptr lds, const int wave_s,
                                              const float* __restrict__ gq1, const float* __restrict__ gq2, const float* __restrict__ ropeq, const LAS int* tcls, const LAS float* tp0, const float* __restrict__ gsub = nullptr, const float lam = 0.f, const float omli = 0.f) {
  constexpr int ND = DQK / 16;
  const int tid = fresh_tid(wave_s), lane = tid & 63, r32 = lane & 31, hi = lane >> 5; const int wid = __builtin_amdgcn_readfirstlane(tid >> 6);
  LAS float* wsf = (LAS float*)(lds + D_OFF_WS) + wid * 64; LAS float* al_l = wsf + 32;
  LAS float* pos_l = (LAS float*)(lds + D_OFF_POS + wid * 512);
  (void)scale;
  unsigned kno[2], vo[2], kro;
#pragma unroll
  for (int i = 0; i < 2; ++i) { const int p = 2 * wid + i;
    { const int row = 4 * p + (lane >> 4), c = (lane & 15) ^ (row & 15); kno[i] = (unsigned)(row * ldk + c * 8) * 2u; }
    { const int st = 2 * p + (lane >> 5), w = lane & 31, kk = (st >> 2) * 8 + (w >> 2), k = (kk & ~0xC) | ((kk & 4) << 1) | ((kk & 8) >> 1), c = (st & 3) * 32 + (w & 3) * 8; vo[i] = (unsigned)(k * ldv + c) * 2u; } }
  { const int row = 8 * wid + (lane >> 3), c = (lane & 7) ^ ((row >> 1) & 7); kro = (DQK == 192) ? (unsigned)(row * 64 + c * 8) * 2u : (unsigned)(row * ldk + c * 8) * 2u; }
  const unsigned pso = (unsigned)lane * 4u;
  const lptr vdst = lds + D_OFF_V + wid * 2048, kndst = lds + D_OFF_KN + wid * 2048, krdst = lds + D_OFF_KR + wid * 1024;
#define DMA_K(t, s) do { if constexpr (DQK == 192) { const char* kb_ = (const char*)Kh + (size_t)(t) * (KVBLK * 2) * ldk; glds16s(kb_, kno[0], kndst + (s) * 16384); glds16s(kb_, kno[1], kndst + (s) * 16384 + 1024); \
      glds16s((const char*)KRh + (size_t)(t) * (KVBLK * 128), kro, krdst + (s) * 8192); } \
    else { glds16s((const char*)Kh + (size_t)(t) * (KVBLK * 2) * ldk, kro, krdst + (s) * 8192); } \
    if constexpr (ALIBI) glds4s((const char*)posk + (size_t)(t) * (KVBLK * 4), pso, (lptr)pos_l + (s) * 256); } while (0)
#define DMA_V(t, s) do { const char* vb_ = (const char*)Vh + (size_t)(t) * (KVBLK * 2) * ldv; glds16s(vb_, vo[0], vdst + (s) * 16384); glds16s(vb_, vo[1], vdst + (s) * 16384 + 1024); } while (0)
#define WAITBAR() asm volatile("s_waitcnt vmcnt(0) lgkmcnt(0)\n\ts_barrier" ::: "memory")
#define RESC(a) do { if (__any((a) < 1.f)) { if (hi == 0) al_l[r32] = (a); asm volatile("s_waitcnt lgkmcnt(0)" ::: "memory"); \
    _Pragma("unroll") for (int d = 0; d < 4; ++d) _Pragma("unroll") for (int r = 0; r < 16; ++r) o[d][r] *= al_l[crow(r, hi)]; } } while (0)
  const int NT = seq / KVBLK;
  DMA_K(0, 0); DMA_V(0, 0); DMA_K(1, 1);
  constexpr int NQR = ND < 8 ? ND : 8;
  float mhat = 0.f, l_reg = 0; f32x16 o[4] = {}; bf16x8 qr[NQR]; f32x16 negm = f32x16{}; if constexpr (!FIXREF) asm volatile("" : "+v"(negm));
  const bf16* Qw = Qb + (long)(wid * QBLK + r32) * ldq + hi * 8;
  const lptr qx = lds + D_OFF_QX + wid * 4096;
  { bf16x8 qv[ND];
#pragma unroll
    for (int d0 = 0; d0 < ND; ++d0) qv[d0] = *(const bf16x8*)(Qw + d0 * 16);
    constexpr int NN = (DQK == 192) ? 8 : 4;
    constexpr float QS = (DQK == 192) ? 0.07216878364870322f * 1.4426950408889634f : 0.125f * 1.4426950408889634f;
    float ssn = 0.f;
#pragma unroll
    for (int d0 = 0; d0 < NN; ++d0) { float f[8]; unpack8(__builtin_bit_cast(u32x4, qv[d0]), f); ssn += ssq8(f); }
    { auto rr = __builtin_amdgcn_permlane32_swap(__float_as_uint(ssn), __float_as_uint(ssn), false, false); ssn = __uint_as_float(rr[0]) + __uint_as_float(rr[1]); }
    const float rn = QS / sqrtf(ssn * (1.f / (16 * NN)) + EPS);
#pragma unroll
    for (int d0 = 0; d0 < NN; ++d0) { float f[8]; unpack8(__builtin_bit_cast(u32x4, qv[d0]), f); const f32x4 g0 = *(const f32x4*)(gq1 + 16 * d0 + 8 * hi), g1 = *(const f32x4*)(gq1 + 16 * d0 + 8 * hi + 4);
#pragma unroll
      for (int e = 0; e < 4; ++e) { f[e] *= rn * g0[e]; f[4 + e] *= rn * g1[e]; }
      qr[d0] = __builtin_bit_cast(bf16x8, pack8(f)); }
    if constexpr (DQK == 192) {
      float ssr = 0.f;
#pragma unroll
      for (int d0 = 8; d0 < 12; ++d0) { float f[8]; unpack8(__builtin_bit_cast(u32x4, qv[d0]), f); ssr += ssq8(f); }
      { auto rr = __builtin_amdgcn_permlane32_swap(__float_as_uint(ssr), __float_as_uint(ssr), false, false); ssr = __uint_as_float(rr[0]) + __uint_as_float(rr[1]); }
      const float rr_ = 1.0f / sqrtf(ssr * (1.f / ROPE) + EPS);
      const float* rp = ropeq + (size_t)(wid * QBLK + r32) * 64;
#pragma unroll
      for (int dd = 0; dd < 2; ++dd) { float x1[8], x2[8], o1[8], o2[8]; unpack8(__builtin_bit_cast(u32x4, qv[8 + dd]), x1); unpack8(__builtin_bit_cast(u32x4, qv[10 + dd]), x2);
        const int i0 = 16 * dd + 8 * hi;
#pragma unroll
        for (int e = 0; e < 8; ++e) { const float a = x1[e] * rr_ * gq2[i0 + e], b = x2[e] * rr_ * gq2[32 + i0 + e]; const float c = rp[2 * (i0 + e)], s = rp[2 * (i0 + e) + 1];
          o1[e] = (a * c - b * s) * QS; o2[e] = (b * c + a * s) * QS; }
        *(LAS u32x4*)(qx + r32 * 128 + ((((2 * dd + hi) ^ (r32 >> 1)) & 7) << 4)) = pack8(o1);
        *(LAS u32x4*)(qx + r32 * 128 + ((((2 * (dd + 2) + hi) ^ (r32 >> 1)) & 7) << 4)) = pack8(o2); } } }
  float pq = 0.f; if constexpr (ALIBI) pq = posq[wid * QBLK + r32];
  const int vb0 = (int)(unsigned)(uintptr_t)(lds + D_OFF_V) + v_rd_base(lane);
  const lptr Kn0 = lds + D_OFF_KN, Kr0 = lds + D_OFF_KR;
  f32x16 pA0, pA1, pB0, pB1; float alA, alB; bf16x8 pa0, pa1, pa2, pa3;
  WAITBAR();
  f32x4 pkv[8];
  bf16x8 kext0 = bf16x8{}, kext1 = bf16x8{}, qext = bf16x8{}; unsigned w0pos = 0u, s3b = 0u; float sp = 0.f;
  if constexpr (ALIBI && DQK == 64) { sp = -nsl;
    const unsigned s1b = cvt_pk_bf16(sp, 0.f) & 0xffffu; const float r1 = sp - __uint_as_float(s1b << 16); const unsigned s2b = cvt_pk_bf16(r1, 0.f) & 0xffffu; const float r2 = r1 - __uint_as_float(s2b << 16);
    s3b = cvt_pk_bf16(r2, 0.f) & 0xffffu; w0pos = s1b | (s2b << 16);
    const unsigned k0b = __float_as_uint((float)r32) >> 16, k1b = __float_as_uint((float)(32 + r32)) >> 16, one = 0x3F80u;
    const u32x4 e0 = {k0b | (k0b << 16), k0b | (one << 16), one | (one << 16), 0u}, e1 = {k1b | (k1b << 16), k1b | (one << 16), one | (one << 16), 0u}, z = {0u, 0u, 0u, 0u};
    kext0 = __builtin_bit_cast(bf16x8, hi ? z : e0); kext1 = __builtin_bit_cast(bf16x8, hi ? z : e1); }
  bool fold = false;
#define FOLD_PREP(j) do { fold = false; if constexpr (ALIBI && DQK == 64) { const int cls_ = __builtin_amdgcn_readfirstlane(tcls[j]); fold = (cls_ != 0); \
    if (fold) { const float P0 = tp0[j]; const float c = ((cls_ == 1) ? -sp : sp) * (pq - P0); \
      const unsigned c1b = cvt_pk_bf16(c, 0.f) & 0xffffu; const float q1 = c - __uint_as_float(c1b << 16); const unsigned c2b = cvt_pk_bf16(q1, 0.f) & 0xffffu; const float q2 = q1 - __uint_as_float(c2b << 16); \
      const unsigned c3b = cvt_pk_bf16(q2, 0.f) & 0xffffu; const unsigned sg = (cls_ == 1) ? 0u : 0x80008000u; \
      const u32x4 w = {w0pos ^ sg, (s3b ^ (sg & 0x8000u)) | (c1b << 16), c2b | (c3b << 16), 0u}, z = {0u, 0u, 0u, 0u}; qext = __builtin_bit_cast(bf16x8, hi ? z : w); } } } while (0)
#define QK_LOAD(KS) do { } while (0)
#define POS_LOAD(KS) do { if (ALIBI && !fold) { _Pragma("unroll") for (int g = 0; g < 4; ++g) { pkv[g] = *(const LAS f32x4*)(pos_l + (KS) * 64 + 8 * g + 4 * hi); pkv[4 + g] = *(const LAS f32x4*)(pos_l + (KS) * 64 + 32 + 8 * g + 4 * hi); } SBAR(); } } while (0)
#define QK_MMA(X0, X1, KS) do { qkt_d<DQK>(X0, X1, Kn0 + (KS) * 16384, Kr0 + (KS) * 8192, qr, qx, negm, r32, hi); \
    if constexpr (DQK == 64) { if (fold) { X0 = __builtin_amdgcn_mfma_f32_32x32x16_bf16(kext0, qext, X0, 0, 0, 0); X1 = __builtin_amdgcn_mfma_f32_32x32x16_bf16(kext1, qext, X1, 0, 0, 0); } } } while (0)
  QK_LOAD(0); POS_LOAD(0); QK_MMA(pA0, pA1, 0);
  if constexpr (FIXREF) { alA = 1.f; alB = 1.f;
    if constexpr (ALIBI) {
#pragma unroll
      for (int g = 0; g < 4; ++g) { const f32x4 a = pkv[g], b = pkv[4 + g];
#pragma unroll
        for (int j = 0; j < 4; ++j) { pA0[4 * g + j] = fmaf(fabsf(a[j] - pq), nsl, pA0[4 * g + j]); pA1[4 * g + j] = fmaf(fabsf(b[j] - pq), nsl, pA1[4 * g + j]); } } }
#pragma unroll
    for (int r = 0; r < 16; ++r) pA0[r] = __builtin_amdgcn_exp2f(pA0[r]); }
  else softmax_a<ALIBI, true>(pA0, pA1, mhat, negm, l_reg, alA, pkv, pq, nsl);
  WAITBAR();
  if (2 < NT) DMA_K(2, 0);
  DMA_V(1, 1);
#define HALF(j, X0, X1, alX, Y0, Y1, KS, VS) do { SBAR(); \
    FOLD_PREP(j); QK_LOAD(KS); sm_exp1(Y1); SBAR(); \
    QK_MMA(X0, X1, KS); sm_sumpack(Y0, Y1, l_reg, pa0, pa1, pa2, pa3); SBAR(); \
    { float mx_ = -3.0e38f; const int vb_ = vb0 + (VS) * 16384; \
      pv_sm_one<ALIBI, 0, FIXREF>(o[0], vb_, pa0, pa1, pa2, pa3, X0, X1, mx_, pos_l + (KS) * 64, hi, pq, nsl, fold); pv_sm_one<ALIBI, 1, FIXREF>(o[1], vb_, pa0, pa1, pa2, pa3, X0, X1, mx_, pos_l + (KS) * 64, hi, pq, nsl, fold); \
      pv_sm_one<ALIBI, 2, FIXREF>(o[2], vb_, pa0, pa1, pa2, pa3, X0, X1, mx_, pos_l + (KS) * 64, hi, pq, nsl, fold); pv_sm_one<ALIBI, 3, FIXREF>(o[3], vb_, pa0, pa1, pa2, pa3, X0, X1, mx_, pos_l + (KS) * 64, hi, pq, nsl, fold); \
      if constexpr (FIXREF) { _Pragma("unroll") for (int r_ = 0; r_ < 16; ++r_) X0[r_] = __builtin_amdgcn_exp2f(X0[r_]); } else sm_tail<false>(X0, X1, mx_, mhat, negm, l_reg, alX); } \
    WAITBAR(); \
    if ((j) + 2 < NT) DMA_K((j) + 2, KS); \
    if ((j) + 1 < NT) DMA_V((j) + 1, (VS)); \
    if constexpr (!FIXREF) RESC(alX); } while (0)
  for (int j = 1; j + 1 < NT; j += 2) {
    HALF(j, pB0, pB1, alB, pA0, pA1, 1, 0);
    HALF(j + 1, pA0, pA1, alA, pB0, pB1, 0, 1);
  }
  HALF(NT - 1, pB0, pB1, alB, pA0, pA1, 1, 0);
  softmax_b(pB0, pB1, l_reg, pa0, pa1, pa2, pa3); SBAR();
  pv_d0(o, vb0 + 16384, pa0, pa1, pa2, pa3);
  { const int te = fresh_tid(wave_s); const int wid_e = te >> 6, r32e = te & 31, hie = (te >> 5) & 1;
    LAS float* li_e = (LAS float*)(lds + D_OFF_WS) + wid_e * 64;
    if (hie == 0) li_e[r32e] = l_reg; asm volatile("s_waitcnt lgkmcnt(0)" ::: "memory");
    float rli[16];
#pragma unroll
    for (int r = 0; r < 16; ++r) rli[r] = __builtin_amdgcn_rcpf(li_e[crow(r, hie)]);
    bf16* Ow = Ob + (long)(wid_e * QBLK) * ldo;
    if constexpr (EPI == 1) {
#pragma unroll
      for (int r = 0; r < 16; ++r) { const unsigned w0 = cvt_pk_bf16(o[0][r] * rli[r], o[1][r] * rli[r]), w1 = cvt_pk_bf16(o[2][r] * rli[r], o[3][r] * rli[r]);
        LAS unsigned* sp = (LAS unsigned*)(lds + (r < 8 ? D_OFF_KN : D_OFF_QX) + ((2 * r) & 15) * 2048 + te * 4); sp[0] = w0; sp[512] = w1; }
    } else if constexpr (EPI == 2) {
      float gv[4];
#pragma unroll
      for (int d0 = 0; d0 < 4; ++d0) gv[d0] = gsub[d0 * 32 + r32e] * omli;
#pragma unroll
      for (int r = 0; r < 16; ++r) { const int orow = crow(r, hie);
        const LAS unsigned* sp = (const LAS unsigned*)(lds + (r < 8 ? D_OFF_KN : D_OFF_QX) + ((2 * r) & 15) * 2048 + te * 4); const unsigned w0 = sp[0], w1 = sp[512];
        float d[4] = {bf_lo(w0), bf_hi(w0), bf_lo(w1), bf_hi(w1)};
        const unsigned v0 = cvt_pk_bf16(o[0][r] * rli[r], o[1][r] * rli[r]), v1 = cvt_pk_bf16(o[2][r] * rli[r], o[3][r] * rli[r]);
        d[0] -= lam * bf_lo(v0); d[1] -= lam * bf_hi(v0); d[2] -= lam * bf_lo(v1); d[3] -= lam * bf_hi(v1);
        float s = (d[0] * d[0] + d[1] * d[1]) + (d[2] * d[2] + d[3] * d[3]);
        s += xshfl<1>(s); s += xshfl<2>(s); s += xshfl<4>(s); s += xshfl<8>(s); s += xshfl<16>(s);
        const float rstd = 1.0f / sqrtf(s * (1.f / 128) + EPS);
#pragma unroll
        for (int d0 = 0; d0 < 4; ++d0) Ow[(long)orow * ldo + d0 * 32 + r32e] = (bf16)(cvt_pk_bf16(d[d0] * rstd * gv[d0], 0.f) & 0xffffu); }
    } else {
#pragma unroll
    for (int r = 0; r < 16; ++r) { const int orow = crow(r, hie);
#pragma unroll
      for (int d0 = 0; d0 < 4; ++d0) Ow[(long)orow * ldo + d0 * 32 + r32e] = (bf16)(cvt_pk_bf16(o[d0][r] * rli[r], 0.f) & 0xffffu); } } }
  asm volatile("s_waitcnt lgkmcnt(0)\n\ts_barrier" ::: "memory");
#undef DMA_K
#undef DMA_V
#undef WAITBAR
#undef RESC
#undef HALF
#undef QK_LOAD
#undef FOLD_PREP
#undef POS_LOAD
#undef QK_MMA
}

typedef int i32x8 __attribute__((ext_vector_type(8)));
constexpr int SC_Q16 = 0x7B7B7B7B;
__device__ __forceinline__ void qkt_f8(f32x16& p0, f32x16& p1, const lptr Kn, const lptr Kr, const i32x8 (&qf)[3], const f32x16& negm, int r32, int hi) {
  const lptr rn = Kn + r32 * 128, rr = Kr + r32 * 64; const int k8 = (r32 >> 1) & 7, k4 = (r32 >> 2) & 3;
#pragma unroll
  for (int s = 0; s < 3; ++s) {
    u32x4 a, b, c, d;
    if (s < 2) { const int c0 = ((4 * s + 2 * hi) ^ k8) << 4, c1 = ((4 * s + 2 * hi + 1) ^ k8) << 4;
      a = *(const LAS u32x4*)(rn + c0); b = *(const LAS u32x4*)(rn + c1); c = *(const LAS u32x4*)(rn + 4096 + c0); d = *(const LAS u32x4*)(rn + 4096 + c1); }
    else { const int c0 = ((2 * hi) ^ k4) << 4, c1 = ((2 * hi + 1) ^ k4) << 4;
      a = *(const LAS u32x4*)(rr + c0); b = *(const LAS u32x4*)(rr + c1); c = *(const LAS u32x4*)(rr + 2048 + c0); d = *(const LAS u32x4*)(rr + 2048 + c1); }
    const i32x8 A0 = {(int)a.x, (int)a.y, (int)a.z, (int)a.w, (int)b.x, (int)b.y, (int)b.z, (int)b.w}, A1 = {(int)c.x, (int)c.y, (int)c.z, (int)c.w, (int)d.x, (int)d.y, (int)d.z, (int)d.w};
    if (s == 0) { p0 = __builtin_amdgcn_mfma_scale_f32_32x32x64_f8f6f4(A0, qf[0], negm, 0, 0, 0, 0, 0, 0); p1 = __builtin_amdgcn_mfma_scale_f32_32x32x64_f8f6f4(A1, qf[0], negm, 0, 0, 0, 0, 0, 0); }
    else { p0 = __builtin_amdgcn_mfma_scale_f32_32x32x64_f8f6f4(A0, qf[s], p0, 0, 0, 0, 0, 0, 0); p1 = __builtin_amdgcn_mfma_scale_f32_32x32x64_f8f6f4(A1, qf[s], p1, 0, 0, 0, 0, 0, 0); } }
}
__device__ __forceinline__ void attn_unit_mla8(const bf16* __restrict__ Qb, int ldq, const unsigned char* __restrict__ K8h, int ldk8, const unsigned char* __restrict__ KR8, const unsigned char* __restrict__ VT8h,
                                               bf16* __restrict__ Ob, int ldo, const int seq, const lptr lds, const int wave_s, const float* __restrict__ gq1, const float* __restrict__ gq2, const float* __restrict__ ropeq) {
  const int tid = fresh_tid(wave_s), lane = tid & 63, r32 = lane & 31, hi = lane >> 5; const int wid = __builtin_amdgcn_readfirstlane(tid >> 6);
  LAS float* wsf = (LAS float*)(lds + D_OFF_WS) + wid * 64; LAS float* al_l = wsf + 32;
  unsigned vo, kno, kro;
  { const int n = 16 * wid + (lane >> 2), g = (lane & 3) ^ ((n >> 2) & 3); vo = (unsigned)(n * 64 + g * 16); }
  { const int row = 8 * wid + (lane >> 3), c = (lane & 7) ^ ((row >> 1) & 7); kno = (unsigned)(row * ldk8 + c * 16); }
  { const int row = 16 * (wid & 3) + (lane >> 2), c = (lane & 3) ^ ((row >> 2) & 3); kro = (unsigned)(row * 64 + c * 16); }
  const lptr vdst = lds + D_OFF_V + wid * 1024, kndst = lds + D_OFF_KN + wid * 1024, krdst = lds + D_OFF_KR + (wid & 3) * 1024;
#define DMA_K(t, s) do { glds16s((const char*)K8h + (size_t)(t) * KVBLK * ldk8, kno, kndst + (s) * 8192); if (wid < 4) glds16s((const char*)KR8 + (size_t)(t) * (KVBLK * 64), kro, krdst + (s) * 4096); } while (0)
#define DMA_V(t, s) glds16s((const char*)VT8h + (size_t)(t) * 8192, vo, vdst + (s) * 8192)
#define WAITBAR() asm volatile("s_waitcnt vmcnt(0) lgkmcnt(0)\n\ts_barrier" ::: "memory")
#define RESC(a) do { if (__any((a) < 1.f)) { if (hi == 0) al_l[r32] = (a); asm volatile("s_waitcnt lgkmcnt(0)" ::: "memory"); \
    _Pragma("unroll") for (int r = 0; r < 16; ++r) { const float a_ = al_l[crow(r, hi)]; o[0][r] *= a_; o[1][r] *= a_; o[2][r] *= a_; o[3][r] *= a_; ol[r] *= a_; } } } while (0)
  const int NT = seq / KVBLK;
  DMA_K(0, 0); DMA_V(0, 0); DMA_K(1, 1); DMA_K(2, 2); DMA_K(3, 3); DMA_V(1, 1); DMA_V(2, 2);
  const i32x8 ones8 = {0x22222222, 0x22222222, 0x22222222, 0x22222222, 0, 0, 0, 0};
  float mhat = 0.f; f32x16 o[4] = {}; f32x16 ol = {}; i32x8 qf[3]; f32x16 negm = f32x16{}; asm volatile("" : "+v"(negm));
  { const bf16* Qw = Qb + (long)(wid * QBLK + r32) * ldq + hi * 32;
    constexpr float QS16 = MLA_SQS;
    u32x4 raw[3][4];
#pragma unroll
    for (int s = 0; s < 3; ++s)
#pragma unroll
      for (int i = 0; i < 4; ++i) raw[s][i] = *(const u32x4*)(Qw + 64 * s + 8 * i);
    float ssn = 0.f, ssr = 0.f;
#pragma unroll
    for (int s = 0; s < 2; ++s)
#pragma unroll
      for (int i = 0; i < 4; ++i) { float f[8]; unpack8(raw[s][i], f); ssn += ssq8(f); }
#pragma unroll
    for (int i = 0; i < 4; ++i) { float f[8]; unpack8(raw[2][i], f); ssr += ssq8(f); }
    { auto rr = __builtin_amdgcn_permlane32_swap(__float_as_uint(ssn), __float_as_uint(ssn), false, false); ssn = __uint_as_float(rr[0]) + __uint_as_float(rr[1]); }
    { auto rr = __builtin_amdgcn_permlane32_swap(__float_as_uint(ssr), __float_as_uint(ssr), false, false); ssr = __uint_as_float(rr[0]) + __uint_as_float(rr[1]); }
    const float rn = QS16 / sqrtf(ssn * (1.f / NOPE) + EPS), rr_ = 1.0f / sqrtf(ssr * (1.f / ROPE) + EPS);
#pragma unroll
    for (int s = 0; s < 2; ++s)
#pragma unroll
      for (int i = 0; i < 4; ++i) { float f[8]; unpack8(raw[s][i], f); const f32x4 g0 = *(const f32x4*)(gq1 + 64 * s + 32 * hi + 8 * i), g1 = *(const f32x4*)(gq1 + 64 * s + 32 * hi + 8 * i + 4);
#pragma unroll
        for (int e = 0; e < 4; ++e) { f[e] *= rn * g0[e]; f[4 + e] *= rn * g1[e]; }
        qf[s][2 * i] = (int)pk4_fp8(f[0], f[1], f[2], f[3]); qf[s][2 * i + 1] = (int)pk4_fp8(f[4], f[5], f[6], f[7]); }
    const float* rp = ropeq + (size_t)(wid * QBLK + r32) * 64;
#pragma unroll
    for (int i = 0; i < 4; ++i) { float f[8], o8[8]; unpack8(raw[2][i], f);
#pragma unroll
      for (int e = 0; e < 8; ++e) { const float x = f[e] * rr_ * gq2[32 * hi + 8 * i + e];
        auto sw = __builtin_amdgcn_permlane32_swap(__float_as_uint(x), __float_as_uint(x), false, false); const float a = __uint_as_float(sw[0]), b = __uint_as_float(sw[1]);
        const float c = rp[2 * (8 * i + e)], s = rp[2 * (8 * i + e) + 1]; o8[e] = (hi ? (b * c + a * s) : (a * c - b * s)) * QS16; }
      qf[2][2 * i] = (int)pk4_fp8(o8[0], o8[1], o8[2], o8[3]); qf[2][2 * i + 1] = (int)pk4_fp8(o8[4], o8[5], o8[6], o8[7]); } }
  const lptr Kn0 = lds + D_OFF_KN, Kr0 = lds + D_OFF_KR;
  const lptr Vr0 = lds + D_OFF_V + r32 * 64 + (((2 * hi) ^ ((r32 >> 2) & 3)) << 4), Vr1 = lds + D_OFF_V + r32 * 64 + (((2 * hi + 1) ^ ((r32 >> 2) & 3)) << 4);
  f32x16 pA0, pA1, pB0, pB1; float alA, alB; i32x8 pa8;
  WAITBAR();
#define QK_MMA(X0, X1, KS) qkt_f8(X0, X1, Kn0 + (KS) * 8192, Kr0 + (KS) * 4096, qf, negm, r32, hi)
#define I8(a, b) (i32x8){(int)a.x, (int)a.y, (int)a.z, (int)a.w, (int)b.x, (int)b.y, (int)b.z, (int)b.w}
#define PV8(D, VS) do { const u32x4 v0_ = *(const LAS u32x4*)(Vr0 + (VS) * 8192 + (D) * 2048), v1_ = *(const LAS u32x4*)(Vr1 + (VS) * 8192 + (D) * 2048); \
    o[D] = __builtin_amdgcn_mfma_scale_f32_32x32x64_f8f6f4(pa8, I8(v0_, v1_), o[D], 0, 0, 0, 0, 0, 0); } while (0)
#define CV8(a, b, c, d) (int)__builtin_amdgcn_cvt_pk_fp8_f32(c, d, __builtin_amdgcn_cvt_pk_fp8_f32(a, b, 0, false), true)
#define SUMPACK8(Y0, Y1) do { \
    _Pragma("unroll") for (int j_ = 0; j_ < 4; ++j_) { pa8[j_] = CV8(Y0[4 * j_], Y0[4 * j_ + 1], Y0[4 * j_ + 2], Y0[4 * j_ + 3]); pa8[4 + j_] = CV8(Y1[4 * j_], Y1[4 * j_ + 1], Y1[4 * j_ + 2], Y1[4 * j_ + 3]); } } while (0)
#define ROWMAX(X0, X1, rm) do { float a_ = MX3(X0[0], X0[1], X1[0]), b_ = MX3(X0[2], X0[3], X1[1]); a_ = MX3(a_, X1[2], X1[3]); \
    _Pragma("unroll") for (int r_ = 4; r_ < 16; r_ += 4) { a_ = MX3(a_, X0[r_], X0[r_ + 1]); b_ = MX3(b_, X0[r_ + 2], X0[r_ + 3]); a_ = MX3(a_, X1[r_], X1[r_ + 1]); b_ = MX3(b_, X1[r_ + 2], X1[r_ + 3]); } \
    rm = fmaxf(a_, b_); { auto rr_ = __builtin_amdgcn_permlane32_swap(__float_as_uint(rm), __float_as_uint(rm), false, false); rm = fmaxf(__uint_as_float(rr_[0]), __uint_as_float(rr_[1])); } } while (0)
#define REREF(X0, X1, dl_) do { mhat += dl_; \
    _Pragma("unroll") for (int r_ = 0; r_ < 16; ++r_) { X0[r_] -= dl_; X1[r_] -= dl_; } \
    _Pragma("unroll") for (int r_ = 0; r_ < 16; ++r_) negm[r_] = -mhat; \
    asm volatile("" : "+v"(negm)); } while (0)
#define EXP16(P) do { _Pragma("unroll") for (int r_ = 0; r_ < 16; ++r_) P[r_] = __builtin_amdgcn_exp2f(P[r_]); } while (0)
  QK_MMA(pA0, pA1, 0);
  { float rm; ROWMAX(pA0, pA1, rm); const float dl = rm - 4.0f; REREF(pA0, pA1, dl); alA = 1.f; EXP16(pA0); }
#define HALF(j, X0, X1, alX, Y0, Y1, KS, VS, BAR) do { SBAR(); \
    EXP16(Y1); SBAR(); \
    QK_MMA(X0, X1, KS); SUMPACK8(Y0, Y1); SBAR(); \
    PV8(0, VS); PV8(1, VS); \
    { float rm_; ROWMAX(X0, X1, rm_); alX = 1.f; \
      if (__builtin_expect(__any(rm_ > 8.0f), 0)) { const float dl_ = fmaxf(rm_ - 4.0f, 0.f); REREF(X0, X1, dl_); alX = __builtin_amdgcn_exp2f(-dl_); } } \
    PV8(2, VS); PV8(3, VS); ol = __builtin_amdgcn_mfma_scale_f32_32x32x64_f8f6f4(pa8, ones8, ol, 0, 4, 0, 0, 0, 0); \
    EXP16(X0); asm volatile("" : "+v"(X0)); SBAR(); \
    if (BAR) { WAITBAR();     \
      if ((j) + 3 < NT) DMA_K((j) + 3, ((KS) + 3) & 3); \
      if ((j) + 2 < NT) DMA_V((j) + 2, ((VS) + 3) & 3); } \
    else { if ((j) + 3 < NT) DMA_K((j) + 3, ((KS) + 3) & 3); if ((j) + 2 < NT) DMA_V((j) + 2, ((VS) + 3) & 3); }     \
    RESC(alX); } while (0)
  for (int j = 1; j + 3 < NT; j += 4) {
    HALF(j, pB0, pB1, alB, pA0, pA1, 1, 0, 1);
    HALF(j + 1, pA0, pA1, alA, pB0, pB1, 2, 1, 0);
    HALF(j + 2, pB0, pB1, alB, pA0, pA1, 3, 2, 1);
    HALF(j + 3, pA0, pA1, alA, pB0, pB1, 0, 3, 0);
  }
  HALF(NT - 3, pB0, pB1, alB, pA0, pA1, 1, 0, 1);
  HALF(NT - 2, pA0, pA1, alA, pB0, pB1, 2, 1, 0);
  HALF(NT - 1, pB0, pB1, alB, pA0, pA1, 3, 2, 1);
  EXP16(pB1); SUMPACK8(pB0, pB1); SBAR();
  PV8(0, 3); PV8(1, 3); PV8(2, 3); PV8(3, 3); ol = __builtin_amdgcn_mfma_scale_f32_32x32x64_f8f6f4(pa8, ones8, ol, 0, 4, 0, 0, 0, 0);
  { const int te = fresh_tid(wave_s); const int wid_e = te >> 6, r32e = te & 31, hie = (te >> 5) & 1;
    float rli[16];
#pragma unroll
    for (int r = 0; r < 16; ++r) rli[r] = 0.25f * __builtin_amdgcn_rcpf(ol[r]);
    bf16* Ow = Ob + (long)(wid_e * QBLK) * ldo;
#pragma unroll
    for (int r = 0; r < 16; ++r) { const int orow = crow(r, hie);
#pragma unroll
      for (int d0 = 0; d0 < 4; ++d0) { if (MLA_GA8) { const float v_ = clamp_fp8(o[d0][r] * rli[r] * 64.0f); ((unsigned char*)Ob)[(long)(wid_e * QBLK + orow) * ldo + d0 * 32 + r32e] = (unsigned char)(__builtin_amdgcn_cvt_pk_fp8_f32(v_, v_, 0, false) & 0xff); }
        else Ow[(long)orow * ldo + d0 * 32 + r32e] = (bf16)(cvt_pk_bf16(o[d0][r] * rli[r], 0.f) & 0xffffu); } } }
  asm volatile("s_waitcnt lgkmcnt(0)\n\ts_barrier" ::: "memory");
#undef DMA_K
#undef DMA_V
#undef WAITBAR
#undef RESC
#undef HALF
#undef QK_MMA
#undef I8
#undef PV8
#undef CV8
#undef SUMPACK8
#undef ROWMAX
#undef REREF
#undef EXP16
}
#undef SBAR
}

constexpr size_t MiB = 1u << 20;
constexpr size_t WS_CTL = 0, CTL_ZERO_BYTES = 1 * MiB;
constexpr size_t WS_ROPE = 1 * MiB;
constexpr size_t WS_POSF = 9 * MiB;
constexpr size_t WS_TMM = WS_POSF + 256 * 1024, WS_QMM = WS_TMM + 8 * 1024, WS_TFL = WS_QMM + 4 * 1024;
constexpr int D_OFF_TT_DUMMY = 0;
constexpr size_t WS_MOE = 10 * MiB;
constexpr size_t MOE_TOPI = WS_MOE, MOE_TOPW = MOE_TOPI + (size_t)T * 2 * 4, MOE_BCNT = MOE_TOPW + (size_t)T * 2 * 4, MOE_TOK = MOE_BCNT + 256 * 16 * 4,
                 MOE_WTL = MOE_TOK + (size_t)2 * NPMAX * 4, MOE_TEX = MOE_WTL + (size_t)2 * NPMAX * 4, MOE_NTR = MOE_TEX + 2 * 256 * 4, MOE_END = MOE_NTR + 64;
static_assert(MOE_END <= 12 * MiB, "routing tables");
constexpr size_t WS_SSQ = 11 * MiB + MiB / 4;
static_assert(MOE_END <= WS_SSQ && WS_SSQ + (size_t)T * 16 <= 12 * MiB, "ssq table");
constexpr size_t WS_W = 12 * MiB, W_LAYER = 20 * MiB + MiB / 2;
constexpr size_t W_1A = 0, W_1B = 2 * MiB, W_UQ = 12 * MiB, W_UKV = 13 * MiB + MiB / 2, W_A = 14 * MiB + MiB / 2, W_B = 16 * MiB + MiB / 2, W_O = 18 * MiB + MiB / 2;
constexpr size_t WS_WGU = 53 * MiB, WS_WD = 64 * MiB;
constexpr size_t WS_R = 70 * MiB;
constexpr size_t R_H = WS_R, R_CQKV = WS_R + 64 * MiB, R_Q = WS_R + 128 * MiB, R_KV = WS_R + 224 * MiB, R_KR = WS_R + 352 * MiB, R_VT8 = WS_R + 356 * MiB, R_OA = WS_R + 406 * MiB;
constexpr size_t R_DQKV = WS_R + 64 * MiB, R_O01 = WS_R + 256 * MiB, R_OB = WS_R + 320 * MiB, R_GATES = WS_R + 128 * MiB, R_PAG = WS_R + 256 * MiB, R_MRG = WS_R + 64 * MiB;
constexpr size_t R_ACTD = WS_R + 64 * MiB;
constexpr size_t R_WMOE = WS_R + 64 * MiB, R_ACTM = WS_R + 232 * MiB;
constexpr size_t WMOE_GU = 14 * MiB, WMOE_D = 7 * MiB;
constexpr size_t WS_END = R_ACTM + (size_t)NPMAX * FFE * 2;
static_assert(WS_END <= 542 * MiB, "d_ws map");
constexpr int CW_BAR = 4096;
constexpr int CW_QUEUE = 8192;

constexpr int LDS_BYTES = 147456;
constexpr int MISC_OFF = 143360;

#define XB_TMO      128
#define XB_XCNT(j)  (256  + 64 * (j))
#define XB_XSUB(j)  (1280 + 64 * (j))
#define XB_XGEN(j)  (2304 + 64 * (j))
#define XB_TOP      3328
#define XB_TOPGEN   3392
#define XCD_BAR_WORDS 3456
#define XB_SPIN_CAP (1u << 18)
__device__ __forceinline__ unsigned xb_ld(unsigned* p)              { return __hip_atomic_load(p, __ATOMIC_RELAXED, __HIP_MEMORY_SCOPE_AGENT); }
__device__ __forceinline__ unsigned xb_add(unsigned* p, unsigned v) { return __hip_atomic_fetch_add(p, v, __ATOMIC_RELAXED, __HIP_MEMORY_SCOPE_AGENT); }
__device__ __forceinline__ unsigned xb_xcc_id() { return (unsigned)__builtin_amdgcn_s_getreg((3 << 11) | 20) & 0xFu; }
#define XB_SPIN(cond, bar) do { unsigned _sp = 0; while (cond) { __builtin_amdgcn_s_sleep(1); \
    if ((++_sp & 255u) == 0u) { if (xb_ld(&(bar)[XB_TMO])) break; if (_sp > XB_SPIN_CAP) { atomicAdd(&(bar)[XB_TMO], 1u); break; } } } } while (0)
struct XcdBarrier { unsigned* bar; unsigned x; volatile LAS unsigned* st; };
__device__ __forceinline__ XcdBarrier xcd_barrier_post(unsigned* bar, volatile LAS unsigned* st) {
    XcdBarrier b; b.bar = bar; b.x = xb_xcc_id(); b.st = st;
    if (threadIdx.x == 0) (void)xb_add(&bar[XB_XCNT(b.x)], 1u);
    return b;
}
__device__ __forceinline__ void xcd_barrier_complete(unsigned* bar, unsigned x, unsigned& nloc, unsigned& nx) {
    const unsigned G = gridDim.x * gridDim.y * gridDim.z;
    unsigned sum, cnt, mine, sp = 0u;
    for (;;) {
        sum = 0u; cnt = 0u; mine = 0u;
#pragma unroll
        for (unsigned j = 0; j < 16; ++j) { const unsigned c = xb_ld(&bar[XB_XCNT(j)]); sum += c; cnt += (c > 0u) ? 1u : 0u; mine = (j == x) ? c : mine; }
        if (sum == G) break;
        __builtin_amdgcn_s_sleep(1);
        if ((++sp & 255u) == 0u) { if (xb_ld(&bar[XB_TMO])) break; if (sp > XB_SPIN_CAP) { atomicAdd(&bar[XB_TMO], 1u); break; } }
    }
    nloc = mine > 0u ? mine : 1u; nx = cnt > 0u ? cnt : 1u;
}
__device__ __forceinline__ void xcd_barrier(const XcdBarrier& b, const bool leader) {
    asm volatile("s_waitcnt vmcnt(0)" ::: "memory");
    __syncthreads();
    if (leader) {
        unsigned* bar = b.bar; asm volatile("" : "+s"(bar));
        __builtin_amdgcn_s_waitcnt(0);
        unsigned bx_ = __builtin_amdgcn_readfirstlane(b.x); asm volatile("" : "+s"(bx_));
        unsigned nloc = b.st[0], nx = b.st[1];
        if (nloc == 0u) { xcd_barrier_complete(bar, bx_, nloc, nx); b.st[0] = nloc; b.st[1] = nx; }
        const unsigned old = xb_add(&bar[XB_XSUB(bx_)], 1u);
        const unsigned gen = old / nloc;
        if (old + 1u == (gen + 1u) * nloc) {
            __builtin_amdgcn_fence(__ATOMIC_RELEASE, "agent");
            asm volatile("s_waitcnt vmcnt(0)" ::: "memory");
            const unsigned og = xb_add(&bar[XB_TOP], 1u);
            const unsigned tg = og / nx;
            if (og + 1u == (tg + 1u) * nx) xb_add(&bar[XB_TOPGEN], 1u);
            else XB_SPIN(xb_ld(&bar[XB_TOPGEN]) == tg, bar);
            __builtin_amdgcn_fence(__ATOMIC_ACQUIRE, "agent");
            xb_add(&bar[XB_XGEN(bx_)], 1u);
            asm volatile("s_waitcnt vmcnt(0)" ::: "memory");
        } else {
            XB_SPIN(xb_ld(&bar[XB_XGEN(bx_)]) == gen, bar);
            __builtin_amdgcn_fence(__ATOMIC_ACQUIRE, "agent");
            asm volatile("s_waitcnt vmcnt(0)" ::: "memory");
        }
    }
    __syncthreads();
}

__device__ const double INV_FREQ[32] = {1, 0.74989420933245587, 0.56234132519034907, 0.42169650342858223, 0.31622776601683794, 0.23713737056616552, 0.17782794100389229, 0.1333521432163324,
    0.10000000000000001, 0.074989420933245579, 0.056234132519034911, 0.042169650342858224, 0.031622776601683791, 0.023713737056616554, 0.017782794100389229, 0.013335214321633241,
    0.01, 0.0074989420933245579, 0.005623413251903491, 0.0042169650342858229, 0.0031622776601683794, 0.0023713737056616554, 0.0017782794100389228, 0.0013335214321633241,
    0.001, 0.00074989420933245586, 0.0005623413251903491, 0.00042169650342858224, 0.00031622776601683794, 0.00023713737056616554, 0.00017782794100389227, 0.0001333521432163324};

__device__ __forceinline__ void tr_tile(const float* __restrict__ W, int N, int k0, int n0, bf16* __restrict__ dst, int ldd, int drow0, const float* __restrict__ ks, LAS float* scr, int lane) {
#pragma unroll
    for (int h = 0; h < 2; ++h) { float v[32];
#pragma unroll
        for (int i = 0; i < 32; ++i) v[i] = W[(size_t)(k0 + 32 * h + i) * N + n0 + lane];
        if (ks) {
#pragma unroll
            for (int i = 0; i < 32; ++i) v[i] *= ks[k0 + 32 * h + i]; }
#pragma unroll
        for (int i = 0; i < 32; ++i) scr[(32 * h + i) * 65 + lane] = v[i]; }
    asm volatile("s_waitcnt lgkmcnt(0)" ::: "memory");
    const int c = lane & 7;
#pragma unroll
    for (int j = 0; j < 8; ++j) { const int n = (lane >> 3) + 8 * j; const LAS float* s = scr + (8 * c) * 65 + n;
        u32x4 o; o.x = cvt_pk_bf16(s[0 * 65], s[1 * 65]); o.y = cvt_pk_bf16(s[2 * 65], s[3 * 65]); o.z = cvt_pk_bf16(s[4 * 65], s[5 * 65]); o.w = cvt_pk_bf16(s[6 * 65], s[7 * 65]);
        *(u32x4*)(dst + (size_t)(drow0 + n) * ldd + k0 + 8 * c) = o; }
    asm volatile("s_waitcnt lgkmcnt(0)" ::: "memory");
}
__device__ __forceinline__ void tr_item(const float* W, int K, int N, bf16* dst, bf16* dst2, int ldd, int mode, int roff, const float* ks, int item, LAS float* scr, int lane) {
    const int nblk = N / 64, kb = item / nblk, nb = item % nblk, k0 = kb * 64, n0 = nb * 64;
    bf16* d = dst; int drow0 = n0 + roff;
    if (mode == 1) { if (n0 >= 832) { d = dst2; drow0 = n0 - 832; } else if (MLA_G1F8) return; }
    else if (mode == 2) drow0 = 256 * (n0 >> 7) + (n0 & 127);
    else if (mode == 3) drow0 = 256 * (n0 >> 7) + 128 + (n0 & 127);
    tr_tile(W, N, k0, n0, d, ldd, drow0, ks, scr, lane);
}
__device__ __forceinline__ void tr_block(const float* __restrict__ W, int N, int k0, int n0, bf16* __restrict__ dst, int ldd, int mode, int roff, LAS float* scr, int tid) {
    const int wave = tid >> 6, lane = tid & 63;
    f32x4 v[8];
#pragma unroll
    for (int r = 0; r < 8; ++r) v[r] = __builtin_nontemporal_load((const f32x4*)(W + (size_t)(k0 + wave * 8 + r) * N + n0 + 4 * lane));
#pragma unroll
    for (int r = 0; r < 8; ++r) { LAS float* s = scr + (wave * 8 + r) * 257 + 4 * lane; s[0] = v[r].x; s[1] = v[r].y; s[2] = v[r].z; s[3] = v[r].w; }
    __syncthreads();
    const int c = tid & 7, nb = tid >> 3;
#pragma unroll
    for (int j = 0; j < 4; ++j) { const int n = nb + 64 * j, na = n0 + n; const LAS float* s = scr + (8 * c) * 257 + n;
        const int drow = (mode == 2) ? 256 * (na >> 7) + (na & 127) : (mode == 3) ? 256 * (na >> 7) + 128 + (na & 127) : na + roff;
        u32x4 o; o.x = cvt_pk_bf16(s[0 * 257], s[1 * 257]); o.y = cvt_pk_bf16(s[2 * 257], s[3 * 257]); o.z = cvt_pk_bf16(s[4 * 257], s[5 * 257]); o.w = cvt_pk_bf16(s[6 * 257], s[7 * 257]);
        *(u32x4*)(dst + (size_t)drow * ldd + k0 + 8 * c) = o; }
    __syncthreads();
}
__device__ __forceinline__ void tr_block8(const float* __restrict__ W, int N, int k0, int n0, unsigned char* __restrict__ dst, int ldd, int mode, int roff, LAS float* scr, int tid) {
    const int wave = tid >> 6, lane = tid & 63;
    f32x4 v[8];
#pragma unroll
    for (int r = 0; r < 8; ++r) v[r] = __builtin_nontemporal_load((const f32x4*)(W + (size_t)(k0 + wave * 8 + r) * N + n0 + 4 * lane));
#pragma unroll
    for (int r = 0; r < 8; ++r) { LAS float* s = scr + (wave * 8 + r) * 257 + 4 * lane; s[0] = v[r].x; s[1] = v[r].y; s[2] = v[r].z; s[3] = v[r].w; }
    __syncthreads();
    const int c = tid & 3, nb = tid >> 2;
#pragma unroll
    for (int j = 0; j < 2; ++j) { const int n = nb + 128 * j, na = n0 + n; const LAS float* s = scr + (16 * c) * 257 + n;
        const int drow = (mode == 2) ? 256 * (na >> 7) + (na & 127) : (mode == 3) ? 256 * (na >> 7) + 128 + (na & 127) : na + roff;
        u32x4 o; o.x = pk4_fp8(32.f * s[0 * 257], 32.f * s[1 * 257], 32.f * s[2 * 257], 32.f * s[3 * 257]); o.y = pk4_fp8(32.f * s[4 * 257], 32.f * s[5 * 257], 32.f * s[6 * 257], 32.f * s[7 * 257]);
        o.z = pk4_fp8(32.f * s[8 * 257], 32.f * s[9 * 257], 32.f * s[10 * 257], 32.f * s[11 * 257]); o.w = pk4_fp8(32.f * s[12 * 257], 32.f * s[13 * 257], 32.f * s[14 * 257], 32.f * s[15 * 257]);
        *(u32x4*)(dst + (size_t)drow * ldd + k0 + 16 * c) = o; }
    __syncthreads();
}
__device__ __forceinline__ void tr_block8x(const float* __restrict__ W, int N, int k0, int n0, unsigned char* __restrict__ dst, int ldd, int nmax, const float* __restrict__ ks, LAS float* scr, int tid) {
    const int wave = tid >> 6, lane = tid & 63;
    f32x4 v[8];
#pragma unroll
    for (int r = 0; r < 8; ++r) v[r] = __builtin_nontemporal_load((const f32x4*)(W + (size_t)(k0 + wave * 8 + r) * N + n0 + 4 * lane));
#pragma unroll
    for (int r = 0; r < 8; ++r) { const float sc = ks ? 32.f * ks[k0 + wave * 8 + r] : 32.f; LAS float* s = scr + (wave * 8 + r) * 257 + 4 * lane; s[0] = sc * v[r].x; s[1] = sc * v[r].y; s[2] = sc * v[r].z; s[3] = sc * v[r].w; }
    __syncthreads();
    const int c = tid & 3, nb = tid >> 2;
#pragma unroll
    for (int j = 0; j < 2; ++j) { const int n = nb + 128 * j, na = n0 + n; const LAS float* s = scr + (16 * c) * 257 + n;
        u32x4 o; o.x = pk4_fp8(s[0 * 257], s[1 * 257], s[2 * 257], s[3 * 257]); o.y = pk4_fp8(s[4 * 257], s[5 * 257], s[6 * 257], s[7 * 257]);
        o.z = pk4_fp8(s[8 * 257], s[9 * 257], s[10 * 257], s[11 * 257]); o.w = pk4_fp8(s[12 * 257], s[13 * 257], s[14 * 257], s[15 * 257]);
        if (na < nmax) *(u32x4*)(dst + (size_t)na * ldd + k0 + 16 * c) = o; }
    __syncthreads();
}
__device__ __forceinline__ void tr_bitem8(const float* W, int K, int N, unsigned char* dst, int ldd, int mode, int roff, int item, LAS float* scr, int tid) {
    const int nblk = N / 256, kb = item / nblk, nb = item % nblk; tr_block8(W, N, kb * 64, nb * 256, dst, ldd, mode, roff, scr, tid);
}
__device__ __forceinline__ void tr_bitem(const float* W, int K, int N, bf16* dst, int ldd, int mode, int roff, int item, LAS float* scr, int tid) {
    const int nblk = N / 256, kb = item / nblk, nb = item % nblk; tr_block(W, N, kb * 64, nb * 256, dst, ldd, mode, roff, scr, tid);
}
__device__ __forceinline__ void norm_load(const float* __restrict__ xrow, int lane, f32x4 (&v)[4]) {
    const f32x4* xr = (const f32x4*)xrow + lane;
#pragma unroll
    for (int j = 0; j < 4; ++j) v[j] = __builtin_nontemporal_load(xr + 64 * j);
}
__device__ __forceinline__ void norm_fin(const float* __restrict__ g, bf16* __restrict__ orow, int lane, f32x4 (&v)[4]) {
    float s = 0.f;
#pragma unroll
    for (int j = 0; j < 4; ++j) s += (v[j].x * v[j].x + v[j].y * v[j].y) + (v[j].z * v[j].z + v[j].w * v[j].w);
    const float rstd = 1.0f / sqrtf(wave_sum(s) * (1.f / DM) + EPS);
    const f32x4* gr = (const f32x4*)g + lane; u32x2* o8 = (u32x2*)orow + lane;
#pragma unroll
    for (int j = 0; j < 4; ++j) { v[j] = v[j] * rstd * gr[64 * j]; u32x2 w; w.x = cvt_pk_bf16(v[j].x, v[j].y); w.y = cvt_pk_bf16(v[j].z, v[j].w); o8[64 * j] = w; }
}
__device__ __forceinline__ void norm_row(const float* __restrict__ xrow, const float* __restrict__ g, bf16* __restrict__ orow, int lane, f32x4 (&v)[4]) { norm_load(xrow, lane, v); norm_fin(g, orow, lane, v); }
__device__ __forceinline__ void norm_fin8(const float* __restrict__ g, unsigned char* __restrict__ orow, int lane, f32x4 (&v)[4]) {
    float s = 0.f;
#pragma unroll
    for (int j = 0; j < 4; ++j) s += (v[j].x * v[j].x + v[j].y * v[j].y) + (v[j].z * v[j].z + v[j].w * v[j].w);
    const float rstd = 1.0f / sqrtf(wave_sum(s) * (1.f / DM) + EPS);
    const f32x4* gr = (const f32x4*)g + lane; unsigned* o4 = (unsigned*)orow + lane;
#pragma unroll
    for (int j = 0; j < 4; ++j) { v[j] = v[j] * rstd * gr[64 * j]; o4[64 * j] = pk4_fp8(v[j].x, v[j].y, v[j].z, v[j].w); }
}
__device__ __forceinline__ void rope8(float (&y)[8], int sub, const float* __restrict__ rope) {
#pragma unroll
    for (int e = 0; e < 8; ++e) { const float yp = xshfl<4>(y[e]); const int i = (sub & 3) * 8 + e; const float c = rope[2 * i], s = rope[2 * i + 1];
        y[e] = (sub < 4) ? (y[e] * c - yp * s) : (y[e] * c + yp * s); }
}
template <int R>
__device__ __forceinline__ void e1_rows(bf16* __restrict__ C, bf16* __restrict__ KRp, const int (&t)[R], const float* __restrict__ g_kr, const float* __restrict__ ropeT, int lane) {
    u32x4 ra[R], rb[R];
#pragma unroll
    for (int i = 0; i < R; ++i) { const bf16* row = C + (size_t)t[i] * 1024; ra[i] = *(const u32x4*)(row + 8 * lane); rb[i] = *(const u32x4*)(row + 512 + 8 * lane); }
#pragma unroll
    for (int i = 0; i < R; ++i) { bf16* row = C + (size_t)t[i] * 1024;
        float fa[8], fb[8]; unpack8(ra[i], fa); unpack8(rb[i], fb);
        const float sa = ssq8(fa), sb = ssq8(fb);
        const float rq = 1.0f / sqrtf(wave_sum(sa) * (1.f / CQ) + EPS);
        const float rkv = 1.0f / sqrtf(wave_sum(lane < 32 ? sb : 0.f) * (1.f / CKV) + EPS);
        const bool iskr = (lane >= 32 && lane < 40);
        const float rkr = 1.0f / sqrtf(wave_sum(iskr ? sb : 0.f) * (1.f / ROPE) + EPS);
        float y[8]; const int sub = lane & 7;
#pragma unroll
        for (int e = 0; e < 8; ++e) { fa[e] *= rq; y[e] = fb[e] * rkr * g_kr[sub * 8 + e]; fb[e] *= rkv; }
        rope8(y, sub, ropeT + (size_t)t[i] * 64);
        *(u32x4*)(row + 8 * lane) = pack8(fa);
        if (lane < 32) *(u32x4*)(row + 512 + 8 * lane) = pack8(fb);
        if (iskr) *(u32x4*)(KRp + (size_t)t[i] * 64 + sub * 8) = pack8(y); }
}
template <int R>
__device__ __forceinline__ void kr_rows(const bf16* __restrict__ C, bf16* __restrict__ KRp, const int (&t)[R], const float* __restrict__ g_kr, const float* __restrict__ ropeT, int lane) {
    u32x4 rb[R];
#pragma unroll
    for (int i = 0; i < R; ++i) rb[i] = *(const u32x4*)(C + (size_t)t[i] * 1024 + 768 + 8 * (lane & 7));
#pragma unroll
    for (int i = 0; i < R; ++i) { float y[8]; unpack8(rb[i], y); const int sub = lane & 7;
        float s = ssq8(y); s += xshfl<1>(s); s += xshfl<2>(s); s += xshfl<4>(s);
        const float rstd = 1.0f / sqrtf(s * (1.f / ROPE) + EPS);
#pragma unroll
        for (int e = 0; e < 8; ++e) y[e] *= rstd * g_kr[sub * 8 + e];
        rope8(y, sub, ropeT + (size_t)t[i] * 64);
        if (MLA_FP8) { if (lane < 8) { u32x2 w; w.x = pk4_fp8(MLA_SQS * y[0], MLA_SQS * y[1], MLA_SQS * y[2], MLA_SQS * y[3]); w.y = pk4_fp8(MLA_SQS * y[4], MLA_SQS * y[5], MLA_SQS * y[6], MLA_SQS * y[7]); *(u32x2*)((unsigned char*)KRp + (size_t)t[i] * 64 + sub * 8) = w; } }
        else if (lane < 8) *(u32x4*)(KRp + (size_t)t[i] * 64 + sub * 8) = pack8(y); }
}
struct G16 { u32x4 a, b; };
__device__ __forceinline__ G16 g16_load(const bf16* __restrict__ p) { G16 r; r.a = *(const u32x4*)p; r.b = *(const u32x4*)(p + 8); return r; }
template <int NL> __device__ __forceinline__ void g16_fin(bf16* __restrict__ p, const G16 r, const float* __restrict__ g, int sub, const float post) {
    float a[8], b[8]; unpack8(r.a, a); unpack8(r.b, b);
    float s = ssq8(a) + ssq8(b);
    s += xshfl<1>(s); s += xshfl<2>(s); if (NL == 8) s += xshfl<4>(s);
    const float rstd = post / sqrtf(s * (1.f / (16 * NL)) + EPS);
#pragma unroll
    for (int e = 0; e < 8; ++e) { a[e] *= rstd * g[sub * 16 + e]; b[e] *= rstd * g[sub * 16 + 8 + e]; }
    *(u32x4*)p = pack8(a); *(u32x4*)(p + 8) = pack8(b);
}
template <int R>
__device__ __forceinline__ void e2_rows(bf16* __restrict__ KVp, const int (&t)[R], const float* g_kn, int lane) {
    const int h = lane >> 3, sub = lane & 7;
    G16 kn[R];
#pragma unroll
    for (int i = 0; i < R; ++i) kn[i] = g16_load(KVp + (size_t)t[i] * (MLA_H * 256) + h * 256 + sub * 16);
#pragma unroll
    for (int i = 0; i < R; ++i) g16_fin<8>(KVp + (size_t)t[i] * (MLA_H * 256) + h * 256 + sub * 16, kn[i], g_kn, sub, 1.0f);
}
template <int R>
__device__ __forceinline__ void e3_rows(bf16* __restrict__ D, const int (&t)[R], const float* g_k, int lane) {
    const int grp = lane >> 2, sub = lane & 3;
    G16 k[R];
#pragma unroll
    for (int i = 0; i < R; ++i) k[i] = g16_load(D + (size_t)t[i] * (3 * DM) + 1024 + grp * 64 + sub * 16);
#pragma unroll
    for (int i = 0; i < R; ++i) g16_fin<4>(D + (size_t)t[i] * (3 * DM) + 1024 + grp * 64 + sub * 16, k[i], g_k, sub, 1.0f);
}
template <int R>
__device__ __forceinline__ void e4_rows(const bf16* __restrict__ O, bf16* __restrict__ OBp, const int (&t)[R], const float* g, float lam, float omli, int lane) {
    const int h = lane >> 3, sub = lane & 7;
    G16 r0[R], r1[R];
#pragma unroll
    for (int i = 0; i < R; ++i) { const bf16* p0 = O + (size_t)t[i] * (2 * DM) + (h * 2) * 128 + sub * 16; r0[i] = g16_load(p0); r1[i] = g16_load(p0 + 128); }
#pragma unroll
    for (int i = 0; i < R; ++i) {
        float a0[8], b0[8], a1[8], b1[8]; unpack8(r0[i].a, a0); unpack8(r0[i].b, b0); unpack8(r1[i].a, a1); unpack8(r1[i].b, b1);
#pragma unroll
        for (int e = 0; e < 8; ++e) { a0[e] -= lam * a1[e]; b0[e] -= lam * b1[e]; }
        float s = ssq8(a0) + ssq8(b0); s += xshfl<1>(s); s += xshfl<2>(s); s += xshfl<4>(s);
        const float rstd = omli / sqrtf(s * (1.f / 128) + EPS);
#pragma unroll
        for (int e = 0; e < 8; ++e) { a0[e] *= rstd * g[sub * 16 + e]; b0[e] *= rstd * g[sub * 16 + 8 + e]; }
        bf16* o = OBp + (size_t)t[i] * DM + h * 128 + sub * 16; *(u32x4*)o = pack8(a0); *(u32x4*)(o + 8) = pack8(b0); }
}
#ifndef MK_MULTI
#define MK_MULTI 0
#endif
constexpr int NPH_LAYER = 20, NPHASES = 1 + NLAYER * NPH_LAYER;
struct Args { const void* in[31]; float* out; unsigned char* ws; int ph_lo, ph_hi; };
__global__ void __launch_bounds__(512, 2) fwd_kernel(Args args) {
    extern __shared__ __attribute__((aligned(16))) unsigned char lds_raw[];
    LAS unsigned char* lds = (LAS unsigned char*)lds_raw;
    volatile LAS unsigned* MISC = (volatile LAS unsigned*)(lds + MISC_OFF);
    const int G = gridDim.x, bx = blockIdx.x, vcu = (G % 8 == 0) ? (bx % 8) * (G / 8) + bx / 8 : bx;
    const int NGW = G * 8;
    const int wave_s = __builtin_amdgcn_readfirstlane((int)threadIdx.x >> 6);
#define MY_TID() fresh_tid(wave_s)
    for (int u = threadIdx.x; u < 32; u += 512) MISC[u] = 0u;
    __syncthreads();
    XcdBarrier bar = xcd_barrier_post((unsigned*)(args.ws + WS_CTL) + CW_BAR, MISC + 8);
#define PHASE_LOCALS int tid_l = MY_TID(); asm volatile("" : "+v"(tid_l)); const int tid = tid_l, lane = tid & 63, wave = __builtin_amdgcn_readfirstlane(tid >> 6); \
    unsigned char* ws = args.ws; asm volatile("" : "+s"(ws)); const int gw = vcu * 8 + wave; (void)gw; (void)lane; (void)tid;
#if MK_MULTI
    const int lo = args.ph_lo, hi = args.ph_hi;
#define IN(k) (lo <= (k) && (k) < hi)
#define SEAM(k) do { if (IN(k) && IN((k) + 1)) xcd_barrier(bar, MY_TID() == 0); } while (0)
#else
#define IN(k) true
#define SEAM(k) xcd_barrier(bar, MY_TID() == 0)
#endif
#define x_in ((const float*)args.in[0])
#define positions ((const int*)args.in[1])
#define xres (args.out)
#define ropeT ((float*)(ws + WS_ROPE))
#define posf ((float*)(ws + WS_POSF))
#define H ((bf16*)(ws + R_H))
#define CQKV ((bf16*)(ws + R_CQKV))
#define Qb ((bf16*)(ws + R_Q))
#define KV ((bf16*)(ws + R_KV))
#define KR ((bf16*)(ws + R_KR))
#define OA ((bf16*)(ws + R_OA))
#define DQKV ((bf16*)(ws + R_DQKV))
#define O01 ((bf16*)(ws + R_O01))
#define OB ((bf16*)(ws + R_OB))
#define GATES ((bf16*)(ws + R_GATES))
#define PAG ((bf16*)(ws + R_PAG))
#define MRG ((bf16*)(ws + R_MRG))
#define ACTD ((bf16*)(ws + R_ACTD))
#define WMOE ((bf16*)(ws + R_WMOE))
#define ACTM ((bf16*)(ws + R_ACTM))
#define WGU ((bf16*)(ws + WS_WGU))
#define WD ((bf16*)(ws + WS_WD))
#define TOPI ((int*)(ws + MOE_TOPI))
#define TOPW ((float*)(ws + MOE_TOPW))
#define BCNT ((int*)(ws + MOE_BCNT))
#define TOK ((int*)(ws + MOE_TOK))
#define WTL ((float*)(ws + MOE_WTL))
#define TEX ((int*)(ws + MOE_TEX))
#define NTR ((int*)(ws + MOE_NTR))

    if (IN(0)) { PHASE_LOCALS
        LAS float* scr = (LAS float*)(lds + wave * 16640);
        constexpr int I_IN = (DM / 64) * (DIN / 64), I_G = (DM / 64) * (2 * DM / 64), I_UQ = (CQ / 64) * (MLA_H * QHD / 64), I_UKV = (CKV / 64) * (MLA_H * 256 / 64), I_SQ = (DM / 64) * (DM / 64);
        constexpr int I_L = I_IN + I_G + I_UQ + I_UKV + 3 * I_SQ, I_FD = (DM / 64) * (FFD / 64);
        constexpr int NITEMS = NLAYER * I_L;
        for (int it = gw; it < NITEMS; it += NGW) {
            int r = it;
            if (r < NLAYER * I_L) { const int L = r / I_L; r -= L * I_L; bf16* wl = (bf16*)(ws + WS_W + L * W_LAYER);
                if (r < I_IN) { tr_item((const float*)args.in[3] + (size_t)L * DM * DIN, DM, DIN, (bf16*)((char*)wl + W_1A), (bf16*)((char*)wl + W_1B), DM, 1, 0, nullptr, r, scr, lane); continue; } r -= I_IN;
                if (r < I_G) { if (MLA_GG8 && (r % (2 * DM / 64)) < DM / 64) continue; tr_item((const float*)args.in[4] + (size_t)L * DM * 2 * DM, DM, 2 * DM, (bf16*)((char*)wl + W_1B), nullptr, DM, 0, 3 * DM, nullptr, r, scr, lane); continue; } r -= I_G;
                if (r < I_UQ) { if (MLA_UPF8) continue; tr_item((const float*)args.in[7] + (size_t)L * CQ * MLA_H * QHD, CQ, MLA_H * QHD, (bf16*)((char*)wl + W_UQ), nullptr, CQ, 0, 0, (const float*)args.in[5] + L * CQ, r, scr, lane); continue; } r -= I_UQ;
                if (r < I_UKV) { if (MLA_UPF8) continue; tr_item((const float*)args.in[8] + (size_t)L * CKV * MLA_H * 256, CKV, MLA_H * 256, (bf16*)((char*)wl + W_UKV), nullptr, CKV, 0, 0, (const float*)args.in[6] + L * CKV, r, scr, lane); continue; } r -= I_UKV;
                const int w = r / I_SQ; r -= w * I_SQ;
                if (MLA_GA8 && w == 0) continue;
                tr_item((const float*)args.in[20 + w] + (size_t)L * DM * DM, DM, DM, (bf16*)((char*)wl + (w == 0 ? W_A : (w == 1 ? W_B : W_O))), nullptr, DM, 0, 0, nullptr, r, scr, lane); continue; }
        }
        { __syncthreads();
            constexpr int I_B = (DM / 64) * (FFD / 256);
            constexpr int I_A8 = MLA_GA8 ? NLAYER * (DM / 64) * (DM / 256) : 0;
            constexpr int I_18 = MLA_G1F8 ? NLAYER * (DM / 64) * 4 : 0;
            constexpr int I_Q8 = (CQ / 64) * (MLA_H * QHD / 256), I_KV8 = (CKV / 64) * (MLA_H * 256 / 256), I_U8 = MLA_UPF8 ? NLAYER * (I_Q8 + I_KV8) : 0;
            constexpr int I_G8 = MLA_GG8 ? NLAYER * (DM / 64) * 4 : 0;
            for (int it = vcu; it < 3 * I_B + I_A8 + I_18 + I_U8 + I_G8; it += G) { int r = it;
                if (r >= 3 * I_B + I_A8 + I_18 + I_U8) { r -= 3 * I_B + I_A8 + I_18 + I_U8; const int Lg = r / ((DM / 64) * 4); r -= Lg * ((DM / 64) * 4);
                    tr_block8x((const float*)args.in[4] + (size_t)Lg * DM * 2 * DM, 2 * DM, (r >> 2) * 64, (r & 3) * 256, (unsigned char*)(ws + WS_W + Lg * W_LAYER + W_1B) + (size_t)3 * DM * DM * 2, DM, DM, nullptr, (LAS float*)lds, tid); continue; }
                if (r >= 3 * I_B + I_A8 + I_18) { r -= 3 * I_B + I_A8 + I_18; const int Lu = r / (I_Q8 + I_KV8); r -= Lu * (I_Q8 + I_KV8);
                    if (r < I_Q8) tr_block8x((const float*)args.in[7] + (size_t)Lu * CQ * MLA_H * QHD, MLA_H * QHD, (r / (MLA_H * QHD / 256)) * 64, (r % (MLA_H * QHD / 256)) * 256, (unsigned char*)(ws + WS_W + Lu * W_LAYER + W_UQ), CQ, MLA_H * QHD, (const float*)args.in[5] + Lu * CQ, (LAS float*)lds, tid);
                    else { r -= I_Q8; tr_block8x((const float*)args.in[8] + (size_t)Lu * CKV * MLA_H * 256, MLA_H * 256, (r / MLA_H) * 64, (r % MLA_H) * 256, (unsigned char*)(ws + WS_W + Lu * W_LAYER + W_UKV), CKV, MLA_H * 256, (const float*)args.in[6] + Lu * CKV, (LAS float*)lds, tid); }
                    continue; }
                if (r >= 3 * I_B + I_A8) { r -= 3 * I_B + I_A8; const int L1 = r / ((DM / 64) * 4); r -= L1 * ((DM / 64) * 4);
                    tr_block8x((const float*)args.in[3] + (size_t)L1 * DM * DIN, DIN, (r >> 2) * 64, (r & 3) * 256, (unsigned char*)(ws + WS_W + L1 * W_LAYER + W_1A), DM, 832, nullptr, (LAS float*)lds, tid); continue; }
                if (r >= 3 * I_B) { r -= 3 * I_B; const int La = r / ((DM / 64) * (DM / 256)); r -= La * ((DM / 64) * (DM / 256));
                    tr_bitem8((const float*)args.in[20] + (size_t)La * DM * DM, DM, DM, (unsigned char*)(ws + WS_W + La * W_LAYER + W_A), DM, 0, 0, r, (LAS float*)lds, tid); continue; }
                if (r < I_B) { if (FP8_UPD) tr_bitem8((const float*)args.in[24], DM, FFD, (unsigned char*)WGU, DM, 2, 0, r, (LAS float*)lds, tid); else tr_bitem((const float*)args.in[24], DM, FFD, WGU, DM, 2, 0, r, (LAS float*)lds, tid); continue; } r -= I_B;
                if (r < I_B) { if (FP8_UPD) tr_bitem8((const float*)args.in[25], DM, FFD, (unsigned char*)WGU, DM, 3, 0, r, (LAS float*)lds, tid); else tr_bitem((const float*)args.in[25], DM, FFD, WGU, DM, 3, 0, r, (LAS float*)lds, tid); continue; } r -= I_B;
                if (FP8_DND) tr_bitem8((const float*)args.in[26], FFD, DM, (unsigned char*)WD, FFD, 0, 0, r, (LAS float*)lds, tid); else tr_bitem((const float*)args.in[26], FFD, DM, WD, FFD, 0, 0, r, (LAS float*)lds, tid); } }
        for (int i = gw * 64 + lane; i < NLAYER * 24576; i += NGW * 64) { const int L = i / 24576, j = i % 24576;
            if (MLA_G1F8) { if (j < 12288) *(u32x4*)((char*)ws + WS_W + L * W_LAYER + W_1A + (size_t)832 * DM + (size_t)j * 16) = (u32x4){0u, 0u, 0u, 0u}; }
            else *(u32x4*)((char*)ws + WS_W + L * W_LAYER + W_1A + (size_t)832 * DM * 2 + (size_t)j * 16) = (u32x4){0u, 0u, 0u, 0u}; }
        for (int i = gw * 64 + lane; i < T * 32; i += NGW * 64) { const int t = i >> 5, f = i & 31; const int p = positions[t];
            const double ang = (double)p * INV_FREQ[f]; const double rev = ang * 0.15915494309189533577; const float fr = (float)(rev - floor(rev));
            ropeT[2 * i] = __builtin_amdgcn_cosf(fr); ropeT[2 * i + 1] = __builtin_amdgcn_sinf(fr);
            if (f == 0) posf[t] = (float)p; }
        for (int j = gw; j < NB * (SEQ / 64); j += NGW) { const float p = (float)positions[j * 64 + lane]; const float mn = -wave_max(-p), mx = wave_max(p);
            const float dd = p - (float)lane; const bool contig = (wave_max(dd) == -wave_max(-dd));
            if (lane == 0) { ((float*)(ws + WS_TMM))[2 * j] = mn; ((float*)(ws + WS_TMM))[2 * j + 1] = mx; ((float*)(ws + WS_TFL))[j] = contig ? 1.f : 0.f; } }
        for (int j = gw; j < NB * (SEQ / 256); j += NGW) { float mn = 3.0e38f, mx = -3.0e38f;
#pragma unroll
            for (int q = 0; q < 4; ++q) { const float p = (float)positions[j * 256 + q * 64 + lane]; mn = fminf(mn, p); mx = fmaxf(mx, p); }
            mn = -wave_max(-mn); mx = wave_max(mx);
            if (lane == 0) { ((float*)(ws + WS_QMM))[2 * j] = mn; ((float*)(ws + WS_QMM))[2 * j + 1] = mx; } }
    }
#if MK_MULTI
    SEAM(0);
#endif

    for (int L = 0; L < NLAYER; ++L) {
        const int pb = 1 + L * NPH_LAYER;
#define WL(off) ((const bf16*)(ws + WS_W + (size_t)L * W_LAYER + (off)))
#define W1A WL(W_1A)
#define W1B WL(W_1B)
#define WUQ WL(W_UQ)
#define WUKV WL(W_UKV)
#define WA WL(W_A)
#define WB WL(W_B)
#define WO WL(W_O)
#define xcur ((L == 0) ? x_in : (const float*)xres)
        const bool moe_layer = (L & 1) != 0;

        if (IN(pb + 0)) { PHASE_LOCALS const float* g = (const float*)args.in[2] + L * DM;
            for (int t = gw; t < T; t += 4 * NGW) { f32x4 v[4][4];
#pragma unroll
                for (int i = 0; i < 4; ++i) norm_load(xcur + (size_t)(t + i * NGW) * DM, lane, v[i]);
#pragma unroll
                for (int i = 0; i < 4; ++i) { norm_fin(g, H + (size_t)(t + i * NGW) * DM, lane, v[i]);
                    if (MLA_G1F8) { unsigned* o4 = (unsigned*)(ws + R_OA + 32 * MiB + (size_t)(t + i * NGW) * DM) + lane;
#pragma unroll
                        for (int j = 0; j < 4; ++j) o4[64 * j] = pk4_fp8(v[i][j].x, v[i][j].y, v[i][j].z, v[i][j].w); } } } }
        SEAM(pb + 0);
        if (IN(pb + 1)) { PHASE_LOCALS pg8::StaticOrder S; S.init(T, 1024, G, bx);
            pg8::EpiBf16G E{CQKV, 1024, 7, 0, 3, nullptr, (LAS float*)(lds + 131072), (float*)(ws + WS_SSQ), 0, MLA_UPF8 ? (unsigned char*)(ws + R_OA) : nullptr};
            if (MLA_G1F8) { pg8::ProbPlain8 P{(const unsigned char*)(ws + R_OA + 32 * MiB), DM, (const unsigned char*)W1A, DM, DM, SC_ONE, SC_W}; pg8::gemm_phase(lds, P, S, E, tid); }
            else { pg8::ProbPlain P{H, DM, W1A, DM, DM}; pg8::gemm_phase(lds, P, S, E, tid); } }
        SEAM(pb + 1);
        if (IN(pb + 3)) { PHASE_LOCALS
            { const float* g_kr = (const float*)args.in[12] + L * ROPE;
              for (int t = gw; t < T; t += 4 * NGW) { const int tt[4] = {t, t + NGW, t + 2 * NGW, t + 3 * NGW}; kr_rows<4>(CQKV, KR, tt, g_kr, ropeT, lane); } }
            { pg8::ProbPlain P{CQKV, 1024, WUQ, CQ, CQ}; pg8::StaticOrder S; S.init(T, MLA_H * QHD, G, bx); pg8::EpiBf16M E{Qb, MLA_H * QHD, 6, (const bf16*)(ws + WS_SSQ), 0, nullptr, 0}; if (MLA_UPF8) { pg8::ProbPlain8 P8{(const unsigned char*)(ws + R_OA), 1024, (const unsigned char*)WUQ, CQ, CQ, SC_ONE, SC_W}; pg8::gemm_phase(lds, P8, S, E, tid); } else pg8::gemm_phase(lds, P, S, E, tid); }
            { pg8::ProbPlain P{CQKV + CQ, 1024, WUKV, CKV, CKV}; pg8::StaticOrder S; S.init(T, MLA_H * 256, G, bx);
              pg8::EpiBf16G E{KV, MLA_H * 256, 5, 0, 0, (const float*)args.in[11] + L * NOPE, (LAS float*)(lds + 131072), (float*)(ws + WS_SSQ), MLA_FP8, nullptr}; if (MLA_UPF8) { pg8::ProbPlain8 P8{(const unsigned char*)(ws + R_OA) + CQ, 1024, (const unsigned char*)WUKV, CKV, CKV, SC_ONE, SC_W}; pg8::gemm_phase(lds, P8, S, E, tid); } else pg8::gemm_phase(lds, P, S, E, tid);
              if (MLA_FP8) { __builtin_amdgcn_fence(__ATOMIC_ACQUIRE, "agent");
                constexpr int nM_ = T / 256, nN_ = MLA_H, nwg_ = nM_ * nN_;
                for (int i = 0; i * G + bx < nwg_; ++i) { pg8::Unit u;
                    { int wgid = i * G + bx; { const int q = nwg_ / pg8::NXCD, r = nwg_ % pg8::NXCD, xcd = wgid % pg8::NXCD, off = wgid / pg8::NXCD; wgid = (xcd < r ? xcd * (q + 1) : r * (q + 1) + (xcd - r) * q) + off; }
                      const int nig = pg8::WGM * nN_, gid = wgid / nig, fm = gid * pg8::WGM, gsz = (nM_ - fm) < pg8::WGM ? (nM_ - fm) : pg8::WGM;
                      u.pm = fm + ((wgid % nig) % gsz); u.pn = (wgid % nig) / gsz; }
                    { const int h = u.pn, row0 = u.pm * 256 + (wave & 3) * 64, ti = ((row0 / SEQ) * MLA_H + h) * (SEQ / 64) + (row0 % SEQ) / 64;
                    const bf16* srcv = KV + (size_t)row0 * (MLA_H * 256) + h * 256 + NOPE + 8 * (lane & 15);
                    unsigned char* dst = ws + R_VT8 + (size_t)ti * 8192 + (size_t)(8 * (lane & 15)) * 64;
#pragma unroll
                    for (int I2 = 0; I2 < 2; ++I2) { const int I = 2 * (wave >> 2) + I2; u32x4 r4[4];
#pragma unroll
                        for (int kk = 0; kk < 4; ++kk) r4[kk] = *(const u32x4*)(srcv + (size_t)(16 * I + 4 * (lane >> 4) + kk) * (MLA_H * 256));
                        float f0[8], f1[8], f2[8], f3[8]; unpack8(r4[0], f0); unpack8(r4[1], f1); unpack8(r4[2], f2); unpack8(r4[3], f3);
                        const int q = 4 * I + (lane >> 4), pos = 32 * (q & 1) + 16 * (q >> 3) + 4 * ((q & 7) >> 1);
#pragma unroll
                        for (int c = 0; c < 8; ++c) *(unsigned*)(dst + c * 64 + pos) = pk4_fp8(4.0f * f0[c], 4.0f * f1[c], 4.0f * f2[c], 4.0f * f3[c]); } } }  } }
        }
        SEAM(pb + 3);
        if (IN(pb + 5)) { PHASE_LOCALS
            constexpr int NU = NB * MLA_H * (SEQ / 256);
            for (int u = vcu; u < NU; u += G) { const int b = u / (MLA_H * 32), h = (u / 32) % MLA_H, qb = u % 32; const size_t r0 = (size_t)b * SEQ, rq = r0 + (size_t)qb * 256;
                if (MLA_FP8) att::attn_unit_mla8(Qb + rq * (MLA_H * QHD) + h * QHD, MLA_H * QHD, (const unsigned char*)(KV + r0 * (MLA_H * 256) + h * 256), MLA_H * 512, (const unsigned char*)KR + r0 * 64,
                                              ws + R_VT8 + (size_t)(b * MLA_H + h) * (SEQ / 64) * 8192, MLA_GA8 ? (bf16*)((unsigned char*)OA + rq * DM + h * MLAV) : OA + rq * DM + h * MLAV, DM, SEQ, (att::lptr)lds, wave_s, (const float*)args.in[9] + L * NOPE, (const float*)args.in[10] + L * ROPE, ropeT + rq * 64);
                else att::attn_unit_dma<QHD, false>(Qb + rq * (MLA_H * QHD) + h * QHD, MLA_H * QHD, KV + r0 * (MLA_H * 256) + h * 256, MLA_H * 256, KR + r0 * 64, KV + r0 * (MLA_H * 256) + h * 256 + NOPE, MLA_H * 256,
                                              OA + rq * DM + h * MLAV, DM, nullptr, nullptr, 0.f, 0.07216878364870322f, SEQ, (att::lptr)lds, wave_s,
                                              (const float*)args.in[9] + L * NOPE, (const float*)args.in[10] + L * ROPE, ropeT + rq * 64, nullptr, nullptr); }
        }
        SEAM(pb + 5);
        if (IN(pb + 6)) { PHASE_LOCALS
            { const float l1 = wave_sum(((const float*)args.in[15])[L * DHD + lane] * ((const float*)args.in[16])[L * DHD + lane]);
              const float l2 = wave_sum(((const float*)args.in[17])[L * DHD + lane] * ((const float*)args.in[18])[L * DHD + lane]);
              float c08 = 0.8f, c1 = 1.0f; asm volatile("" : "+v"(c08), "+v"(c1));
              const float lam_init = c08 - 0.6f * expf(-0.3f * (float)L); MISC[21] = __float_as_uint(expf(l1) - expf(l2) + lam_init); MISC[22] = __float_as_uint(c1 - lam_init); }
            pg8::ProbPlain P{H, DM, W1B, DM, DM}; pg8::StaticOrder S; S.init(T, 3 * DM, G, bx);
            pg8::EpiBf16G E{DQKV, 3 * DM, 4, 4, 8, (const float*)args.in[14] + L * DHD, (LAS float*)(lds + 131072), nullptr, 0, nullptr};
            pg8::gemm_phase(lds, P, S, E, tid); }
        SEAM(pb + 6);
        if (IN(pb + 8)) { PHASE_LOCALS
            constexpr int NU = NB * DH * (SEQ / 256);
            const float gq = wave_max(fabsf(((const float*)args.in[13])[L * DHD + lane])), gk = wave_max(fabsf(((const float*)args.in[14])[L * DHD + lane]));
            MISC[20] = __float_as_uint(2.0f * (8.0f * gq * gk * 1.02f) + 27.0f); MISC[24] = __float_as_uint(8.0f * gq * gk * 1.02f);
            MISC[23] = (8.0f * gq * gk * 1.02f * 1.4426950408889634f <= 60.0f) ? 1u : 0u;
            unsigned* qhead = (unsigned*)(ws + WS_CTL) + CW_QUEUE + 64 * L;
            const float* tmm = (const float*)(ws + WS_TMM); const float* qmm = (const float*)(ws + WS_QMM);
            for (;;) {
                const int tq = fresh_tid(wave_s), lq = tq & 63;
                if (tq == 0) MISC[16] = __hip_atomic_fetch_add(qhead, 1u, __ATOMIC_RELAXED, __HIP_MEMORY_SCOPE_AGENT);
                __syncthreads();
                const int i = __builtin_amdgcn_readfirstlane((int)MISC[16]);
                __syncthreads();
                if (i >= NU) break;
                const int h = 7 - (i >> 7), r = i & 127, b = r >> 5, qb = r & 31; const size_t r0 = (size_t)b * SEQ, rq = r0 + (size_t)qb * 256;
                const float slope = exp2f(-(float)(h + 1));
                const float qmn = qmm[2 * (b * 32 + qb)], qmx = qmm[2 * (b * 32 + qb) + 1];
                { const int row = tq >> 1, hf = tq & 1; const float* gqp = (const float*)args.in[13] + L * DHD + hf * 32;
#pragma unroll
                  for (int c = 0; c < 2; ++c) { const bf16* qp = DQKV + (rq + row) * (3 * DM) + (h * 2 + c) * DHD + hf * 32; float sq = 0.f, dt = 0.f;
#pragma unroll
                      for (int p = 0; p < 4; ++p) { float qf[8], kf[8]; unpack8(*(const u32x4*)(qp + 8 * p), qf); unpack8(*(const u32x4*)(qp + DM + 8 * p), kf);
#pragma unroll
                          for (int e = 0; e < 8; ++e) { sq += qf[e] * qf[e]; dt += qf[e] * gqp[8 * p + e] * kf[e]; } }
                      sq += xshfl<1>(sq); dt += xshfl<1>(dt);
                      const float sii = dt * (1.0f / sqrtf(sq * (1.f / DHD) + EPS)) * 0.125f;
                      const float wmn = -wave_max(-sii); if (lq == 0) MISC[40 + 8 * c + (tq >> 6)] = __float_as_uint(wmn); } }
                __syncthreads();
                int t_lo_c[2], t_hi_c[2];
#pragma unroll
                for (int c = 0; c < 2; ++c) { float smin = __uint_as_float(MISC[40 + 8 * c]);
#pragma unroll
                    for (int w = 1; w < 8; ++w) smin = fminf(smin, __uint_as_float(MISC[40 + 8 * c + w]));
                    const float Bs = __uint_as_float(MISC[24]); const float margin = fminf(__uint_as_float(MISC[20]), Bs + 27.25f - smin);
                    unsigned long long m0, m1;
                    { const float k0n = tmm[2 * (b * 128 + lq)], k0x = tmm[2 * (b * 128 + lq) + 1], k1n = tmm[2 * (b * 128 + 64 + lq)], k1x = tmm[2 * (b * 128 + 64 + lq) + 1];
                      const float d0 = fmaxf(0.f, fmaxf(k0n - qmx, qmn - k0x)), d1 = fmaxf(0.f, fmaxf(k1n - qmx, qmn - k1x));
                      m0 = __ballot(slope * d0 <= margin); m1 = __ballot(slope * d1 <= margin); }
                    int t_lo = m0 ? (int)__builtin_ctzll(m0) : 64 + (int)__builtin_ctzll(m1), t_hi = m1 ? 127 - (int)__builtin_clzll(m1) : 63 - (int)__builtin_clzll(m0);
                    if (((t_hi - t_lo + 1) & 1) != 0) { if (t_hi < 127) ++t_hi; else --t_lo; }
                    t_lo_c[c] = __builtin_amdgcn_readfirstlane(t_lo); t_hi_c[c] = __builtin_amdgcn_readfirstlane(t_hi); }
                { LAS int* tc = (LAS int*)(lds + att::D_OFF_TT); LAS float* tp = (LAS float*)(lds + att::D_OFF_TT + 512); const float* tfl = (const float*)(ws + WS_TFL);
#pragma unroll
                  for (int q2 = 0; q2 < 2; ++q2) { const int tj = lq + 64 * q2; const float kn = tmm[2 * (b * 128 + tj)], kx = tmm[2 * (b * 128 + tj) + 1];
                      const int cl = (tfl[b * 128 + tj] != 0.f) ? ((kx <= qmn) ? 1 : ((kn >= qmx) ? 2 : 0)) : 0; tc[tj] = cl; tp[tj] = kn; } }
                const bool fixref = __builtin_amdgcn_readfirstlane((int)MISC[23]) != 0;
                { const int hc = h * 2; const int t_lo = t_lo_c[0], t_hi = t_hi_c[0]; const size_t k0 = r0 + (size_t)t_lo * 64;
                  if (fixref) att::attn_unit_dma<DHD, true, 1, true>(DQKV + rq * (3 * DM) + hc * DHD, 3 * DM, DQKV + k0 * (3 * DM) + DM + hc * DHD, 3 * DM, nullptr, DQKV + k0 * (3 * DM) + 2 * DM + h * 128, 3 * DM,
                                             OB + rq * DM + h * 128, DM, posf + rq, posf + k0, -slope * 1.4426950408889634f, 0.125f, (t_hi - t_lo + 1) * 64, (att::lptr)lds, wave_s,
                                             (const float*)args.in[13] + L * DHD, nullptr, nullptr, (const LAS int*)(lds + att::D_OFF_TT) + t_lo, (const LAS float*)(lds + att::D_OFF_TT + 512) + t_lo);
                  else att::attn_unit_dma<DHD, true, 1>(DQKV + rq * (3 * DM) + hc * DHD, 3 * DM, DQKV + k0 * (3 * DM) + DM + hc * DHD, 3 * DM, nullptr, DQKV + k0 * (3 * DM) + 2 * DM + h * 128, 3 * DM,
                                             OB + rq * DM + h * 128, DM, posf + rq, posf + k0, -slope * 1.4426950408889634f, 0.125f, (t_hi - t_lo + 1) * 64, (att::lptr)lds, wave_s,
                                             (const float*)args.in[13] + L * DHD, nullptr, nullptr, (const LAS int*)(lds + att::D_OFF_TT) + t_lo, (const LAS float*)(lds + att::D_OFF_TT + 512) + t_lo); }
                { const int hc = h * 2 + 1; const int t_lo = t_lo_c[1], t_hi = t_hi_c[1]; const size_t k0 = r0 + (size_t)t_lo * 64; const float lam = __uint_as_float(MISC[21]), omli = __uint_as_float(MISC[22]);
                  if (fixref) att::attn_unit_dma<DHD, true, 2, true>(DQKV + rq * (3 * DM) + hc * DHD, 3 * DM, DQKV + k0 * (3 * DM) + DM + hc * DHD, 3 * DM, nullptr, DQKV + k0 * (3 * DM) + 2 * DM + h * 128, 3 * DM,
                                             OB + rq * DM + h * 128, DM, posf + rq, posf + k0, -slope * 1.4426950408889634f, 0.125f, (t_hi - t_lo + 1) * 64, (att::lptr)lds, wave_s,
                                             (const float*)args.in[13] + L * DHD, nullptr, nullptr, (const LAS int*)(lds + att::D_OFF_TT) + t_lo, (const LAS float*)(lds + att::D_OFF_TT + 512) + t_lo,
                                             (const float*)args.in[19] + L * 128, lam, omli);
                  else att::attn_unit_dma<DHD, true, 2>(DQKV + rq * (3 * DM) + hc * DHD, 3 * DM, DQKV + k0 * (3 * DM) + DM + hc * DHD, 3 * DM, nullptr, DQKV + k0 * (3 * DM) + 2 * DM + h * 128, 3 * DM,
                                             OB + rq * DM + h * 128, DM, posf + rq, posf + k0, -slope * 1.4426950408889634f, 0.125f, (t_hi - t_lo + 1) * 64, (att::lptr)lds, wave_s,
                                             (const float*)args.in[13] + L * DHD, nullptr, nullptr, (const LAS int*)(lds + att::D_OFF_TT) + t_lo, (const LAS float*)(lds + att::D_OFF_TT + 512) + t_lo,
                                             (const float*)args.in[19] + L * 128, lam, omli); } }
        }
        SEAM(pb + 8);
#if MK_MULTI
        SEAM(pb + 9);
#endif
        if (IN(pb + 10)) { PHASE_LOCALS
            if (MLA_GG8) { pg8::StaticOrder S; S.init(T, DM, G, bx);
                { pg8::ProbPlain8 P{(const unsigned char*)(ws + R_OA + 32 * MiB), DM, (const unsigned char*)(W1B + (size_t)3 * DM * DM), DM, DM, SC_ONE, SC_W}; pg8::EpiBf16M E{GATES, 2 * DM, 1, nullptr, 0, nullptr, 0}; pg8::gemm_phase(lds, P, S, E, tid); }
                { pg8::ProbPlain P{H, DM, W1B + (size_t)4 * DM * DM, DM, DM}; pg8::EpiBf16M E{GATES + DM, 2 * DM, 1, nullptr, 0, nullptr, 0}; pg8::gemm_phase(lds, P, S, E, tid); } }
            else { pg8::ProbPlain P{H, DM, W1B + (size_t)3 * DM * DM, DM, DM}; pg8::StaticOrder S; S.init(T, 2 * DM, G, bx); pg8::EpiBf16M E{GATES, 2 * DM, 1, nullptr, 0, nullptr, 0};
                pg8::gemm_phase(lds, P, S, E, tid); } }
#if MK_MULTI || !MLA_GG8
        SEAM(pb + 10);
#endif
        if (IN(pb + 11)) { PHASE_LOCALS pg8::StaticOrder S; S.init(T, DM, G, bx); pg8::EpiBf16M E{PAG, DM, 2, GATES, 2 * DM, nullptr, 0};
            if (MLA_GA8) { pg8::ProbPlain8 P{(const unsigned char*)OA, DM, (const unsigned char*)WA, DM, DM, SC_OA, SC_W}; pg8::gemm_phase(lds, P, S, E, tid); }
            else { pg8::ProbPlain P{OA, DM, WA, DM, DM}; pg8::gemm_phase(lds, P, S, E, tid); } }
#if MK_MULTI || !MLA_GG8
        SEAM(pb + 11);
#endif
        if (IN(pb + 12)) { PHASE_LOCALS pg8::ProbPlain P{OB, DM, WB, DM, DM}; pg8::StaticOrder S; S.init(T, DM, G, bx); pg8::EpiBf16M E{MRG, DM, 3, GATES + DM, 2 * DM, PAG, DM};
            pg8::gemm_phase(lds, P, S, E, tid); }
        SEAM(pb + 12);
        if (IN(pb + 13)) { PHASE_LOCALS pg8::ProbPlain P{MRG, DM, WO, DM, DM}; pg8::StaticOrder S; S.init(T, DM, G, bx); pg8::EpiF32Res E{xcur, xres, DM};
            pg8::gemm_phase(lds, P, S, E, tid); }
        SEAM(pb + 13);
        if (IN(pb + 14)) { PHASE_LOCALS const float* g = (const float*)args.in[23] + L * DM;
            if (!moe_layer) { for (int t = gw; t < T; t += 4 * NGW) { f32x4 v[4][4];
#pragma unroll
                for (int i = 0; i < 4; ++i) norm_load(xres + (size_t)(t + i * NGW) * DM, lane, v[i]);
#pragma unroll
                for (int i = 0; i < 4; ++i) { if (FP8_UPD) norm_fin8(g, (unsigned char*)H + (size_t)(t + i * NGW) * DM, lane, v[i]); else norm_fin(g, H + (size_t)(t + i * NGW) * DM, lane, v[i]); } } }
            else {
                const int j = L >> 1;
                { LAS float* scr = (LAS float*)lds;
                  constexpr int I_GU = (DM / 64) * (FFE / 256), I_D = (FFE / 64) * (DM / 256), I_E = 2 * I_GU + I_D;
                  for (int it = vcu; it < NEXP * I_E; it += G) { const int e = it / I_E; int r = it - e * I_E;
                      char* wgu = (char*)WMOE + (size_t)e * WMOE_GU; char* wd = (char*)WMOE + (size_t)NEXP * WMOE_GU + (size_t)e * WMOE_D;
                      if (r < I_GU) { if (FP8_UP) tr_bitem8((const float*)args.in[28] + ((size_t)j * NEXP + e) * DM * FFE, DM, FFE, (unsigned char*)wgu, DM, 2, 0, r, scr, tid); else tr_bitem((const float*)args.in[28] + ((size_t)j * NEXP + e) * DM * FFE, DM, FFE, (bf16*)wgu, DM, 2, 0, r, scr, tid); continue; } r -= I_GU;
                      if (r < I_GU) { if (FP8_UP) tr_bitem8((const float*)args.in[29] + ((size_t)j * NEXP + e) * DM * FFE, DM, FFE, (unsigned char*)wgu, DM, 3, 0, r, scr, tid); else tr_bitem((const float*)args.in[29] + ((size_t)j * NEXP + e) * DM * FFE, DM, FFE, (bf16*)wgu, DM, 3, 0, r, scr, tid); continue; } r -= I_GU;
                      if (FP8_DN) tr_bitem8((const float*)args.in[30] + ((size_t)j * NEXP + e) * FFE * DM, FFE, DM, (unsigned char*)wd, FFE, 0, 0, r, scr, tid); else tr_bitem((const float*)args.in[30] + ((size_t)j * NEXP + e) * FFE * DM, FFE, DM, (bf16*)wd, FFE, 0, 0, r, scr, tid); } }
                __syncthreads();
                LAS float* wr_l = (LAS float*)lds; LAS int* sel = (LAS int*)(lds + 32768);
                { const float* wr = (const float*)args.in[27] + (size_t)j * DM * NEXP;
                  for (int i = tid; i < DM * NEXP; i += 512) wr_l[(i & 7) * DM + (i >> 3)] = wr[i]; }
                __syncthreads();
                for (int c = bx; c < T / 128; c += G) {
                    for (int rr = 0; rr < 16; ++rr) { const int tl = wave * 16 + rr, t = c * 128 + tl; f32x4 v[4]; norm_load(xres + (size_t)t * DM, lane, v); if (FP8_UP) norm_fin8(g, (unsigned char*)H + (size_t)t * DM, lane, v); else norm_fin(g, H + (size_t)t * DM, lane, v);
                        float lg[NEXP];
#pragma unroll
                        for (int e = 0; e < NEXP; ++e) { float s = 0.f;
#pragma unroll
                            for (int q = 0; q < 4; ++q) { const f32x4 w = *(const LAS f32x4*)(wr_l + e * DM + 4 * lane + 256 * q); s += (v[q].x * w.x + v[q].y * w.y) + (v[q].z * w.z + v[q].w * w.w); }
                            lg[e] = wave_sum(s); }
                        int i0 = 0; float v0 = lg[0];
#pragma unroll
                        for (int e = 1; e < NEXP; ++e) if (lg[e] > v0) { v0 = lg[e]; i0 = e; }
                        int i1 = -1; float v1 = -3.0e38f;
#pragma unroll
                        for (int e = 0; e < NEXP; ++e) if (e != i0 && lg[e] > v1) { v1 = lg[e]; i1 = e; }
                        const float w0 = 1.0f / (1.0f + expf(v1 - v0));
                        if (lane == 0) { TOPI[2 * t] = i0; TOPI[2 * t + 1] = i1; TOPW[2 * t] = w0; TOPW[2 * t + 1] = 1.0f - w0; sel[2 * tl] = i0; sel[2 * tl + 1] = i1; } }
                    __syncthreads();
                    if (tid < 16) { const int p = tid >> 3, e = tid & 7; int n = 0; for (int i = 0; i < 128; ++i) n += (sel[2 * i + p] == e) ? 1 : 0; BCNT[c * 16 + tid] = n; }
                    __syncthreads();
                }
            }
        }
        SEAM(pb + 14);
        if (!moe_layer) {
            if (IN(pb + 15)) { PHASE_LOCALS pg8::StaticOrder S; S.init(T, 2 * FFD, G, bx);
                if (FP8_UPD && FP8_DND) { pg8::ProbPlain8 P{(const unsigned char*)H, DM, (const unsigned char*)WGU, DM, DM, SC_ONE, SC_W}; pg8::EpiSwiGLU8 E{(unsigned char*)ACTD, FFD}; pg8::gemm_phase(lds, P, S, E, tid); }
                else if (FP8_UPD) { pg8::ProbPlain8 P{(const unsigned char*)H, DM, (const unsigned char*)WGU, DM, DM, SC_ONE, SC_W}; pg8::EpiSwiGLU E{ACTD, FFD}; pg8::gemm_phase(lds, P, S, E, tid); }
                else if (FP8_DND) { pg8::ProbPlain P{H, DM, WGU, DM, DM}; pg8::EpiSwiGLU8 E{(unsigned char*)ACTD, FFD}; pg8::gemm_phase(lds, P, S, E, tid); }
                else { pg8::ProbPlain P{H, DM, WGU, DM, DM}; pg8::EpiSwiGLU E{ACTD, FFD}; pg8::gemm_phase(lds, P, S, E, tid); } }
            SEAM(pb + 15);
            if (IN(pb + 16)) { PHASE_LOCALS pg8::StaticOrder S; S.init(T, DM, G, bx); pg8::EpiF32Res E{xres, xres, DM};
                if (FP8_DND) { pg8::ProbPlain8 P{(const unsigned char*)ACTD, FFD, (const unsigned char*)WD, FFD, FFD, SC_ACT, SC_W}; pg8::gemm_phase(lds, P, S, E, tid); }
                else { pg8::ProbPlain P{ACTD, FFD, WD, FFD, FFD}; pg8::gemm_phase(lds, P, S, E, tid); } }
            if (L + 1 < NLAYER) { SEAM(pb + 16); }
        } else {
            if (IN(pb + 15)) { PHASE_LOCALS
                LAS int* cnt_l = (LAS int*)lds;
                LAS int* tot_l = (LAS int*)(lds + 16384);
                LAS int* sel = (LAS int*)(lds + 16384 + 256);
                for (int i = tid; i < 256 * 16; i += 512) cnt_l[i] = BCNT[i];
                __syncthreads();
                if (tid < 16) { int s = 0; for (int c = 0; c < 256; ++c) s += cnt_l[c * 16 + tid]; tot_l[tid] = s; }
                __syncthreads();
                if (tid < 16) { const int p = tid >> 3, e = tid & 7; int b = 0; for (int e2 = 0; e2 < e; ++e2) b += (tot_l[p * 8 + e2] + 255) & ~255; tot_l[16 + tid] = b; }
                __syncthreads();
                for (int c = bx; c < T / 128; c += G) {
                    if (tid < 16) { int s = 0; for (int c2 = 0; c2 < c; ++c2) s += cnt_l[c2 * 16 + tid]; tot_l[32 + tid] = s; }
                    if (tid < 128) { sel[2 * tid] = TOPI[2 * (c * 128 + tid)]; sel[2 * tid + 1] = TOPI[2 * (c * 128 + tid) + 1]; }
                    __syncthreads();
                    if (tid < 128) { const int t = c * 128 + tid;
#pragma unroll
                        for (int p = 0; p < 2; ++p) { const int e = sel[2 * tid + p]; int rank = 0; for (int i = 0; i < tid; ++i) rank += (sel[2 * i + p] == e) ? 1 : 0;
                            const int pos = tot_l[16 + p * 8 + e] + tot_l[32 + p * 8 + e] + rank; TOK[p * NPMAX + pos] = t; WTL[p * NPMAX + pos] = TOPW[2 * t + p]; } }
                    if (c < 16) { const int p = c >> 3; const int b0 = tot_l[16 + c] + tot_l[c], b1 = tot_l[16 + c] + ((tot_l[c] + 255) & ~255);
                        for (int i = b0 + tid; i < b1; i += 512) { TOK[p * NPMAX + i] = -1; WTL[p * NPMAX + i] = 0.f; } }
                    if (c == 0) { if (tid < 2) NTR[tid] = (tot_l[16 + tid * 8 + 7] + ((tot_l[tid * 8 + 7] + 255) & ~255)) >> 8;
                        if (tid < 2 * 256) { const int p = tid >> 8, jt = tid & 255; int e = 0; for (int e2 = 1; e2 < NEXP; ++e2) if (jt * 256 >= tot_l[16 + p * 8 + e2]) e = e2; TEX[p * 256 + jt] = e; } }
                    __syncthreads();
                }
            }
            SEAM(pb + 15);
            const int jm = L >> 1;
            for (int p = 0; p < 2; ++p) {
                if (IN(pb + 16 + 2 * p)) { PHASE_LOCALS const int ntr = __builtin_amdgcn_readfirstlane(NTR[p]);
                    pg8::StaticOrder S; S.init(ntr * 256, 2 * FFE, G, bx);
                    if (FP8_UP && FP8_DN) { pg8::ProbMoeUp8 P{(const unsigned char*)H, DM, (const unsigned char*)WMOE, DM, DM, (size_t)WMOE_GU, TOK + p * NPMAX, TEX + p * 256, SC_ONE, SC_W}; pg8::EpiSwiGLU8 E{(unsigned char*)ACTM + (size_t)p * NPMAX * FFE, FFE}; pg8::gemm_phase(lds, P, S, E, tid); }
                    else if (FP8_UP) { pg8::ProbMoeUp8 P{(const unsigned char*)H, DM, (const unsigned char*)WMOE, DM, DM, (size_t)WMOE_GU, TOK + p * NPMAX, TEX + p * 256, SC_ONE, SC_W}; pg8::EpiSwiGLU E{ACTM, FFE}; pg8::gemm_phase(lds, P, S, E, tid); }
                    else if (FP8_DN) { pg8::ProbMoeUp P{H, DM, WMOE, DM, DM, (size_t)WMOE_GU / 2, TOK + p * NPMAX, TEX + p * 256}; pg8::EpiSwiGLU8 E{(unsigned char*)ACTM, FFE}; pg8::gemm_phase(lds, P, S, E, tid); }
                    else { pg8::ProbMoeUp P{H, DM, WMOE, DM, DM, (size_t)WMOE_GU / 2, TOK + p * NPMAX, TEX + p * 256}; pg8::EpiSwiGLU E{ACTM, FFE}; pg8::gemm_phase(lds, P, S, E, tid); } }
            }
            static_assert(FP8_UP && FP8_DN, "both routing slots' activations (e4m3) share the activation region");
            SEAM(pb + 16);
            for (int p = 0; p < 2; ++p) {
                if (IN(pb + 17 + 2 * p)) { PHASE_LOCALS const int ntr = __builtin_amdgcn_readfirstlane(NTR[p]);
                    pg8::StaticOrder S; S.init(ntr * 256, DM, G, bx); pg8::EpiMoeDown E{xres, DM, TOK + p * NPMAX, WTL + p * NPMAX};
                    if (FP8_DN) { pg8::ProbMoeDown8 P{(const unsigned char*)ACTM + (size_t)p * NPMAX * FFE, FFE, (const unsigned char*)WMOE + (size_t)NEXP * WMOE_GU, FFE, FFE, (size_t)WMOE_D, TEX + p * 256, SC_ACT, SC_W}; pg8::gemm_phase(lds, P, S, E, tid); }
                    else { pg8::ProbMoeDown P{ACTM, FFE, (const bf16*)((const char*)WMOE + (size_t)NEXP * WMOE_GU), FFE, FFE, (size_t)WMOE_D / 2, TEX + p * 256}; pg8::gemm_phase(lds, P, S, E, tid); } }
                if (p == 0 || L + 1 < NLAYER) SEAM(pb + 17 + 2 * p);
            }
            (void)jm;
        }
    }
#undef IN
#undef SEAM
}

#ifndef DBG_STOP
#define DBG_STOP (NPHASES - 1)
#endif
#ifndef DBG_DUMP_OFF
#define DBG_DUMP_OFF 0
#endif
__global__ void dbg_dump(const unsigned short* src, float* out, size_t n) { for (size_t i = (size_t)blockIdx.x * blockDim.x + threadIdx.x; i < n; i += (size_t)gridDim.x * blockDim.x) out[i] = __uint_as_float(((unsigned)src[i]) << 16); }
extern "C" void kernel_launch(void* const* d_in, const int* in_sizes, int n_in, void* d_out, int out_size, void* d_ws, size_t ws_size, hipStream_t stream) {
    static int grid = 0;
    if (grid == 0) {
        if (n_in != 31 || in_sizes[0] != T * DM || out_size != T * DM || ws_size < WS_END) {
            fprintf(stderr, "kernel_launch: built for 31 inputs, x/out of %d floats, >= %zu bytes of workspace; got n_in %d, in0 %d, out %d, ws %zu; nothing launched\n", T * DM, (size_t)WS_END, n_in, n_in > 0 ? in_sizes[0] : -1, out_size, ws_size);
            grid = -1; return; }
        int dev = 0, cus = 0, per_cu = 0;
        if (hipGetDevice(&dev) != hipSuccess || hipDeviceGetAttribute(&cus, hipDeviceAttributeMultiprocessorCount, dev) != hipSuccess) { grid = -1; return; }
        if (hipFuncSetAttribute((const void*)fwd_kernel, hipFuncAttributeMaxDynamicSharedMemorySize, LDS_BYTES) != hipSuccess) { fprintf(stderr, "kernel_launch: hipFuncSetAttribute failed\n"); grid = -1; return; }
        if (hipOccupancyMaxActiveBlocksPerMultiprocessor(&per_cu, (const void*)fwd_kernel, 512, LDS_BYTES) != hipSuccess || per_cu < 1)
            fprintf(stderr, "kernel_launch: note: occupancy query reports %d workgroups per CU\n", per_cu);
        (void)hipGetLastError();
        grid = cus;
    }
    if (grid < 0) return;
    if (hipMemsetAsync((char*)d_ws + WS_CTL, 0, CTL_ZERO_BYTES, stream) != hipSuccess) return;
    Args a{};
    for (int i = 0; i < 31; ++i) a.in[i] = d_in[i];
    a.out = (float*)d_out; a.ws = (unsigned char*)d_ws;
#if MK_MULTI
    for (int ph = 0; ph <= DBG_STOP; ++ph) { a.ph_lo = ph; a.ph_hi = ph + 1; hipLaunchKernelGGL(fwd_kernel, dim3(grid), dim3(512), LDS_BYTES, stream, a); }
    if (DBG_DUMP_OFF) hipLaunchKernelGGL(dbg_dump, dim3(2048), dim3(256), 0, stream, (const unsigned short*)((const char*)d_ws + (size_t)DBG_DUMP_OFF), (float*)d_out, (size_t)T * DM);
#else
    a.ph_lo = 0; a.ph_hi = NPHASES;
    hipLaunchKernelGGL(fwd_kernel, dim3(grid), dim3(512), LDS_BYTES, stream, a);
#endif
}
```
